# Optimizing an MI355X kernel written in HIP

```python
import math
import jax
import jax.numpy as jnp
from jax import lax
import numpy as np

D_MODEL = 1024
BATCH = 8
SEQ = 4096
DEPTH = 4

GRID_W = 64
CTX_LEN = 256
N_MIXERS = 3
NORM_EPS = 1e-6

MLA_HEADS = 16
MLA_Q_LORA = 384
MLA_KV_LORA = 256
MLA_NOPE = 64
MLA_ROPE = 32
MLA_V = 64
MLA_QK = MLA_NOPE + MLA_ROPE
ROPE_AXIS_FREQS = MLA_ROPE // 4
ROPE_THETA = 10000.0
Q_BLOCK = 128

S5_GROUP = 16
S5_GROUPS = D_MODEL // S5_GROUP
S5_STATE = 64
S5_DT_MIN = 0.01
S5_DT_MAX = 0.1
S5_MAX_RE = -1e-4

POOL_WINDOWS = (2, 4, 8, 16)
POOL_GROUP = D_MODEL // len(POOL_WINDOWS)

FFN_DIM = 2816
N_EXPERTS = 8
TOP_K = 2
EXPERT_DIM = 2816

N_MLA_LAYERS = (DEPTH + 2) // 3
N_S5_LAYERS = (DEPTH + 1) // 3
N_POOL_LAYERS = DEPTH // 3
N_DENSE_LAYERS = (DEPTH + 1) // 2
N_MOE_LAYERS = DEPTH // 2

kernel_name = 'hybrid_mla_s5_pool_moe_diffusion'


def rmsnorm(x, g):
    x32 = x.astype(jnp.float32)
    y = x32 * lax.rsqrt(jnp.mean(x32 * x32, axis=-1, keepdims=True) + NORM_EPS)
    return (y * g.astype(jnp.float32)).astype(x.dtype)


def modulate(h, shift, scale):
    return h * (1 + scale) + shift


def rope_2d(x, ang):
    b, l, h, r = x.shape
    xr = x.reshape(b, l, h, 2, 2, r // 4)
    cos = jnp.cos(ang).astype(x.dtype)[None, :, None]
    sin = jnp.sin(ang).astype(x.dtype)[None, :, None]
    x1, x2 = xr[..., 0, :], xr[..., 1, :]
    out = jnp.stack([x1 * cos - x2 * sin, x2 * cos + x1 * sin], axis=-2)
    return out.reshape(b, l, h, r)


def attend(q, k, v):
    s = jnp.einsum('bqhd,bkhd->bhqk', q, k, preferred_element_type=jnp.float32) * (MLA_QK ** -0.5)
    p = jax.nn.softmax(s, axis=-1).astype(v.dtype)
    return jnp.einsum('bhqk,bkhd->bqhd', p, v)


def mla_project_q(h, w_dq, q_norm, w_uq):
    b, l, _ = h.shape
    q = rmsnorm(h @ w_dq, q_norm) @ w_uq
    return q.reshape(b, l, MLA_HEADS, MLA_QK)


def mla_project_kv(h, w_dkv, kv_norm, w_ukv):
    b, l, _ = h.shape
    kv = h @ w_dkv
    c_kv = rmsnorm(kv[..., :MLA_KV_LORA], kv_norm)
    k_rope = kv[..., MLA_KV_LORA:][:, :, None, :]
    ukv = (c_kv @ w_ukv).reshape(b, l, MLA_HEADS, MLA_NOPE + MLA_V)
    return ukv[..., :MLA_NOPE], k_rope, ukv[..., MLA_NOPE:]


def mla_full_keys(k_nope, k_rope):
    return jnp.concatenate([k_nope, jnp.broadcast_to(k_rope, k_nope.shape[:-1] + (MLA_ROPE,))], axis=-1)


def mla_mixer(h_lat, h_ctx, ang, w_dq, q_norm, w_uq, w_dkv, kv_norm, w_ukv, w_o, ctx_out):
    b, l, _ = h_lat.shape
    lc = h_ctx.shape[1]
    q_l = mla_project_q(h_lat, w_dq, q_norm, w_uq)
    q_l = jnp.concatenate([q_l[..., :MLA_NOPE], rope_2d(q_l[..., MLA_NOPE:], ang)], axis=-1)
    kn_l, kr_l, v_l = mla_project_kv(h_lat, w_dkv, kv_norm, w_ukv)
    k_l = mla_full_keys(kn_l, rope_2d(kr_l, ang))
    kn_c, kr_c, v_c = mla_project_kv(h_ctx, w_dkv, kv_norm, w_ukv)
    k_c = mla_full_keys(kn_c, kr_c)
    k_all = jnp.concatenate([k_c, k_l], axis=1)
    v_all = jnp.concatenate([v_c, v_l], axis=1)
    n_blocks = l // Q_BLOCK
    q_blocks = q_l.reshape(b, n_blocks, Q_BLOCK, MLA_HEADS, MLA_QK).transpose(1, 0, 2, 3, 4)
    o_l = lax.map(lambda qb: attend(qb, k_all, v_all), q_blocks)
    o_l = o_l.transpose(1, 0, 2, 3, 4).reshape(b, l, MLA_HEADS * MLA_V)
    y_l = o_l @ w_o
    y_c = None
    if ctx_out:
        q_c = mla_project_q(h_ctx, w_dq, q_norm, w_uq)
        y_c = attend(q_c, k_c, v_c).reshape(b, lc, MLA_HEADS * MLA_V) @ w_o
    return y_l, y_c


def ssm_combine(e1, e2):
    a1, b1 = e1
    a2, b2 = e2
    return a1 * a2, a2 * b1 + b2


def ssm_scan(lam_bar, bu, reverse):
    a = jnp.broadcast_to(lam_bar, (1, bu.shape[1]) + lam_bar.shape)
    _, s = lax.associative_scan(ssm_combine, (a, bu), reverse=reverse, axis=1)
    return s


def s5_glu(y, w_glu):
    g = jax.nn.gelu(y)
    val, gate = jnp.split(g @ w_glu, 2, axis=-1)
    return val * jax.nn.sigmoid(gate)


def s5_mixer(h_lat, h_ctx, a_re, a_im, log_dt, b_re, b_im, c_re, c_im, d, w_glu, ctx_out):
    f32 = jnp.float32
    b, l, dm = h_lat.shape
    lc = h_ctx.shape[1]
    d_g = d.astype(f32).reshape(S5_GROUPS, S5_GROUP)
    u_l = h_lat.astype(f32).reshape(b, l, S5_GROUPS, S5_GROUP)
    u_c = h_ctx.astype(f32).reshape(b, lc, S5_GROUPS, S5_GROUP)
    y_l = d_g * u_l
    y_c = d_g * u_c if ctx_out else None
    steps = jnp.arange(1, l + 1, dtype=f32)
    for direction in range(2):
        reverse = direction == 1
        lam = lax.complex(jnp.minimum(a_re[direction].astype(f32), S5_MAX_RE), a_im[direction].astype(f32))
        lam_dt = lam * jnp.exp(log_dt[direction].astype(f32))[:, None]
        lam_bar = jnp.exp(lam_dt)
        b_bar = ((lam_bar - 1.0) / lam)[..., None] * lax.complex(b_re[direction].astype(f32), b_im[direction].astype(f32))
        c_mat = lax.complex(c_re[direction].astype(f32), c_im[direction].astype(f32))
        s_c = ssm_scan(lam_bar, jnp.einsum('blgn,gpn->blgp', u_c.astype(jnp.complex64), b_bar), reverse)
        s0 = s_c[:, 0] if reverse else s_c[:, -1]
        carry = jnp.exp(lam_dt[None] * (steps[::-1] if reverse else steps)[:, None, None])
        s_l = ssm_scan(lam_bar, jnp.einsum('blgn,gpn->blgp', u_l.astype(jnp.complex64), b_bar), reverse) + carry[None] * s0[:, None]
        y_l = y_l + jnp.real(jnp.einsum('blgp,gnp->blgn', s_l, c_mat))
        if ctx_out:
            y_c = y_c + jnp.real(jnp.einsum('blgp,gnp->blgn', s_c, c_mat))
    out_l = s5_glu(y_l.reshape(b, l, dm).astype(h_lat.dtype), w_glu)
    out_c = s5_glu(y_c.reshape(b, lc, dm).astype(h_ctx.dtype), w_glu) if ctx_out else None
    return out_l, out_c


def centred_pool_residual(h, window):
    b, l, ch = h.shape
    h32 = h.astype(jnp.float32)
    cs = jnp.concatenate([jnp.zeros((b, 1, ch), jnp.float32), jnp.cumsum(h32, axis=1)], axis=1)
    t = jnp.arange(l)
    lo = jnp.clip(t - window // 2, 0, l)
    hi = jnp.clip(t + window - window // 2, 0, l)
    mean = (cs[:, hi] - cs[:, lo]) / (hi - lo).astype(jnp.float32)[None, :, None]
    return mean - h32


def pool_mixer(h, w_pool, scale):
    b, l, dm = h.shape
    groups = [centred_pool_residual(h[..., g * POOL_GROUP:(g + 1) * POOL_GROUP], w) for g, w in enumerate(POOL_WINDOWS)]
    p = jnp.stack(groups, axis=2).astype(h.dtype)
    y = jnp.einsum('blgc,gcd->blgd', p, w_pool).reshape(b, l, dm)
    return y * scale


def swiglu(h, w_gu, w_down):
    g, u = jnp.split(h @ w_gu, 2, axis=-1)
    return (jax.nn.silu(g) * u) @ w_down


def moe_swiglu(h, w_router, b_router, w_gu, w_down):
    logits = jnp.einsum('bld,de->ble', h, w_router, preferred_element_type=jnp.float32) + b_router.astype(jnp.float32)
    top_val, top_idx = lax.top_k(logits, TOP_K)
    top_w = jax.nn.softmax(top_val, axis=-1)
    gates = jnp.einsum('blk,blke->ble', top_w, jax.nn.one_hot(top_idx, N_EXPERTS, dtype=jnp.float32)).astype(h.dtype)
    out = jnp.zeros_like(h)
    for e in range(N_EXPERTS):
        out = out + gates[..., e:e + 1] * swiglu(h, w_gu[e], w_down[e])
    return out


def setup_inputs(seed: int = 0) -> dict:
    key = jax.random.key(seed)
    ks = iter(list(jax.random.split(key, 40)))
    f32 = jnp.float32
    dm = D_MODEL
    g_, p_, n_ = S5_GROUPS, S5_STATE, S5_GROUP

    def nrm(shape, scale):
        return jax.random.normal(next(ks), shape, f32) * scale

    def gain(shape):
        return 1.0 + nrm(shape, 0.02)

    a_im0 = jnp.pi * jnp.arange(p_, dtype=f32)
    return {
        'x': nrm((BATCH, SEQ, dm), 1.0),
        'c': nrm((BATCH, dm), 1.0),
        'ctx': nrm((BATCH, CTX_LEN, dm), 1.0),
        'c_ctx': nrm((dm,), 1.0),
        'norm1_g': gain((DEPTH, dm)),
        'norm2_g': gain((DEPTH, dm)),
        'ada_w': nrm((DEPTH, dm, 6 * dm), 0.5 * dm ** -0.5),
        'ada_b': nrm((DEPTH, 6 * dm), 0.02),
        'final_norm_g': gain((dm,)),
        'mla_w_dq': nrm((N_MLA_LAYERS, dm, MLA_Q_LORA), dm ** -0.5),
        'mla_q_norm': gain((N_MLA_LAYERS, MLA_Q_LORA)),
        'mla_w_uq': nrm((N_MLA_LAYERS, MLA_Q_LORA, MLA_HEADS * MLA_QK), MLA_Q_LORA ** -0.5),
        'mla_w_dkv': nrm((N_MLA_LAYERS, dm, MLA_KV_LORA + MLA_ROPE), dm ** -0.5),
        'mla_kv_norm': gain((N_MLA_LAYERS, MLA_KV_LORA)),
        'mla_w_ukv': nrm((N_MLA_LAYERS, MLA_KV_LORA, MLA_HEADS * (MLA_NOPE + MLA_V)), MLA_KV_LORA ** -0.5),
        'mla_w_o': nrm((N_MLA_LAYERS, MLA_HEADS * MLA_V, dm), (MLA_HEADS * MLA_V) ** -0.5),
        's5_a_re': -0.5 + nrm((N_S5_LAYERS, 2, g_, p_), 0.01),
        's5_a_im': a_im0 + nrm((N_S5_LAYERS, 2, g_, p_), 0.01),
        's5_log_dt': jax.random.uniform(next(ks), (N_S5_LAYERS, 2, g_), f32, math.log(S5_DT_MIN), math.log(S5_DT_MAX)),
        's5_b_re': nrm((N_S5_LAYERS, 2, g_, p_, n_), (2 * n_) ** -0.5),
        's5_b_im': nrm((N_S5_LAYERS, 2, g_, p_, n_), (2 * n_) ** -0.5),
        's5_c_re': nrm((N_S5_LAYERS, 2, g_, n_, p_), p_ ** -0.5),
        's5_c_im': nrm((N_S5_LAYERS, 2, g_, n_, p_), p_ ** -0.5),
        's5_d': nrm((N_S5_LAYERS, dm), 1.0),
        's5_w_glu': nrm((N_S5_LAYERS, dm, 2 * dm), dm ** -0.5),
        'pool_w': nrm((N_POOL_LAYERS, len(POOL_WINDOWS), POOL_GROUP, POOL_GROUP), POOL_GROUP ** -0.5),
        'pool_scale': gain((N_POOL_LAYERS, dm)),
        'ffn_w_gu': nrm((N_DENSE_LAYERS, dm, 2 * FFN_DIM), dm ** -0.5),
        'ffn_w_down': nrm((N_DENSE_LAYERS, FFN_DIM, dm), FFN_DIM ** -0.5),
        'moe_w_router': nrm((N_MOE_LAYERS, dm, N_EXPERTS), dm ** -0.5),
        'moe_b_router': nrm((N_MOE_LAYERS, N_EXPERTS), 0.01),
        'moe_w_gu': nrm((N_MOE_LAYERS, N_EXPERTS, dm, 2 * EXPERT_DIM), dm ** -0.5),
        'moe_w_down': nrm((N_MOE_LAYERS, N_EXPERTS, EXPERT_DIM, dm), EXPERT_DIM ** -0.5),
    }


def reference(x, c, ctx, c_ctx, norm1_g, norm2_g, ada_w, ada_b, final_norm_g,
              mla_w_dq, mla_q_norm, mla_w_uq, mla_w_dkv, mla_kv_norm, mla_w_ukv, mla_w_o,
              s5_a_re, s5_a_im, s5_log_dt, s5_b_re, s5_b_im, s5_c_re, s5_c_im, s5_d, s5_w_glu,
              pool_w, pool_scale, ffn_w_gu, ffn_w_down,
              moe_w_router, moe_b_router, moe_w_gu, moe_w_down):
    b, l, dm = x.shape
    rows = l // GRID_W
    row = jnp.repeat(jnp.arange(rows, dtype=jnp.float32), GRID_W)
    col = jnp.tile(jnp.arange(GRID_W, dtype=jnp.float32), rows)
    inv_freq = 1.0 / (ROPE_THETA ** (jnp.arange(ROPE_AXIS_FREQS, dtype=jnp.float32) / ROPE_AXIS_FREQS))
    ang = jnp.stack([row[:, None] * inv_freq, col[:, None] * inv_freq], axis=1)
    silu_c = jax.nn.silu(c)
    silu_cc = jax.nn.silu(c_ctx)
    xl, xc = x, ctx
    for i in range(DEPTH):
        last = i == DEPTH - 1
        mod_l = [m[:, None, :] for m in jnp.split(silu_c @ ada_w[i] + ada_b[i], 6, axis=-1)]
        mod_c = jnp.split(silu_cc @ ada_w[i] + ada_b[i], 6, axis=-1)
        hl = modulate(rmsnorm(xl, norm1_g[i]), mod_l[0], mod_l[1])
        hc = modulate(rmsnorm(xc, norm1_g[i]), mod_c[0], mod_c[1])
        kind = i % N_MIXERS
        j = i // N_MIXERS
        if kind == 0:
            yl, yc = mla_mixer(hl, hc, ang, mla_w_dq[j], mla_q_norm[j], mla_w_uq[j], mla_w_dkv[j],
                               mla_kv_norm[j], mla_w_ukv[j], mla_w_o[j], not last)
        elif kind == 1:
            yl, yc = s5_mixer(hl, hc, s5_a_re[j], s5_a_im[j], s5_log_dt[j], s5_b_re[j], s5_b_im[j],
                              s5_c_re[j], s5_c_im[j], s5_d[j], s5_w_glu[j], not last)
        else:
            yl = pool_mixer(hl, pool_w[j], pool_scale[j])
            yc = None if last else pool_mixer(hc, pool_w[j], pool_scale[j])
        xl = xl + mod_l[2] * yl
        if not last:
            xc = xc + mod_c[2] * yc
        k = i // 2
        hl = modulate(rmsnorm(xl, norm2_g[i]), mod_l[3], mod_l[4])
        if i % 2 == 0:
            xl = xl + mod_l[5] * swiglu(hl, ffn_w_gu[k], ffn_w_down[k])
        else:
            xl = xl + mod_l[5] * moe_swiglu(hl, moe_w_router[k], moe_b_router[k], moe_w_gu[k], moe_w_down[k])
        if not last:
            hc = modulate(rmsnorm(xc, norm2_g[i]), mod_c[3], mod_c[4])
            if i % 2 == 0:
                xc = xc + mod_c[5] * swiglu(hc, ffn_w_gu[k], ffn_w_down[k])
            else:
                xc = xc + mod_c[5] * moe_swiglu(hc, moe_w_router[k], moe_b_router[k], moe_w_gu[k], moe_w_down[k])
    return rmsnorm(xl, final_norm_g)
```

```cpp
#define MOE_WGM 4
#include <hip/hip_runtime.h>
#include <hip/hip_bf16.h>
#include <cstdio>
#include <cstdint>

#define LAS __attribute__((address_space(3)))
#define GAS __attribute__((address_space(1)))
typedef unsigned short bf16_t;
typedef short bf16x8 __attribute__((ext_vector_type(8)));
typedef short s16x4 __attribute__((ext_vector_type(4)));
typedef float f32x4 __attribute__((ext_vector_type(4)));
typedef float f32x2 __attribute__((ext_vector_type(2)));
typedef float f32x16 __attribute__((ext_vector_type(16)));
typedef unsigned u32x4 __attribute__((ext_vector_type(4)));
typedef unsigned u32x2 __attribute__((ext_vector_type(2)));

constexpr int DM = 1024, NB = 8, SEQ = 4096, CTX = 256;
constexpr int NLAT = NB * SEQ;
constexpr int NCTX = NB * CTX;
constexpr int MT = NLAT + NCTX;
constexpr int QLORA = 384, KVLORA = 256, ROPE = 32, NHEAD = 16, QKD = 96, VD = 64;
constexpr int ZW = 768;
constexpr int FFN = 2816, NEXP = 8;
constexpr float EPS = 1e-6f;
constexpr int NKEY = CTX + SEQ;
constexpr float ATT_C2 = 0.10206207261596577f * 1.4426950408889634f;

__device__ __forceinline__ unsigned f2bf(float f) { unsigned u = __builtin_bit_cast(unsigned, f); return (u + 0x7fffu + ((u >> 16) & 1u)) >> 16; }
__device__ __forceinline__ float bf2f(unsigned short b) { return __builtin_bit_cast(float, ((unsigned)b) << 16); }
__device__ __forceinline__ unsigned cvt_pk_bf16(float lo, float hi) { unsigned r; asm volatile("v_cvt_pk_bf16_f32 %0, %1, %2" : "=v"(r) : "v"(lo), "v"(hi)); return r; }
__device__ __forceinline__ unsigned pk2(float lo, float hi) { return cvt_pk_bf16(lo, hi); }
__device__ __forceinline__ float wave_sum(float v) {
#pragma unroll
    for (int o = 1; o < 64; o <<= 1) v += __shfl_xor(v, o);
    return v;
}
template <int CTRL, int ROWMASK> __device__ __forceinline__ float dpp_f(float v) { return __int_as_float(__builtin_amdgcn_update_dpp(0, __float_as_int(v), CTRL, ROWMASK, 0xF, true)); }
__device__ __forceinline__ float wave_sum_dpp(float v) {
    v += dpp_f<0xB1, 0xF>(v); v += dpp_f<0x4E, 0xF>(v); v += dpp_f<0x141, 0xF>(v); v += dpp_f<0x140, 0xF>(v);
    v += dpp_f<0x142, 0xA>(v); v += dpp_f<0x143, 0xC>(v);
    return __int_as_float(__builtin_amdgcn_readlane(__float_as_int(v), 63));
}
__device__ __forceinline__ float sigmoidf_(float x) { return __builtin_amdgcn_rcpf(1.0f + __builtin_amdgcn_exp2f(x * -1.4426950408889634f)); }
__device__ __forceinline__ float siluf_(float x) { return x * sigmoidf_(x); }
__device__ __forceinline__ float gelu_tanh(float x) { const float u = 1.5957691216057308f * (x + 0.044715f * x * x * x); return x * sigmoidf_(u); }

#define XB_TMO      128
#define XB_XCNT(j)  (256  + 64 * (j))
#define XB_XSUB(j)  (1280 + 64 * (j))
#define XB_XGEN(j)  (2304 + 64 * (j))
#define XB_TOP      3328
#define XB_TOPGEN   3392
#define XCD_BAR_WORDS 3456
#define XB_SPIN_CAP (1u << 18)
__device__ __forceinline__ unsigned xb_ld(unsigned* p)              { return __hip_atomic_load(p, __ATOMIC_RELAXED, __HIP_MEMORY_SCOPE_AGENT); }
__device__ __forceinline__ unsigned xb_add(unsigned* p, unsigned v) { return __hip_atomic_fetch_add(p, v, __ATOMIC_RELAXED, __HIP_MEMORY_SCOPE_AGENT); }
__device__ __forceinline__ unsigned xb_xcc_id() { return (unsigned)__builtin_amdgcn_s_getreg((3 << 11) | 20) & 0xFu; }
#define XB_SPIN(cond, bar) do { unsigned _sp = 0; while (cond) { __builtin_amdgcn_s_sleep(1); \
    if ((++_sp & 255u) == 0u) { if (xb_ld(&(bar)[XB_TMO])) break; if (_sp > XB_SPIN_CAP) { atomicAdd(&(bar)[XB_TMO], 1u); break; } } } } while (0)
struct XcdBarrier { unsigned* bar; unsigned x; volatile LAS unsigned* st; };
__device__ __forceinline__ XcdBarrier xcd_barrier_post(unsigned* bar, volatile LAS unsigned* st) {
    XcdBarrier b; b.bar = bar; b.x = xb_xcc_id(); b.st = st;
    if (threadIdx.x == 0) (void)xb_add(&bar[XB_XCNT(b.x)], 1u);
    return b;
}
__device__ __forceinline__ void xcd_barrier_complete(unsigned* bar, unsigned x, unsigned& nloc, unsigned& nx) {
    const unsigned G = gridDim.x * gridDim.y * gridDim.z;
    unsigned sum, cnt, mine, sp = 0u;
    for (;;) {
        sum = 0u; cnt = 0u; mine = 0u;
#pragma unroll
        for (unsigned j = 0; j < 16; ++j) { const unsigned c = xb_ld(&bar[XB_XCNT(j)]); sum += c; cnt += (c > 0u) ? 1u : 0u; mine = (j == x) ? c : mine; }
        if (sum == G) break;
        __builtin_amdgcn_s_sleep(1);
        if ((++sp & 255u) == 0u) { if (xb_ld(&bar[XB_TMO])) break; if (sp > XB_SPIN_CAP) { atomicAdd(&bar[XB_TMO], 1u); break; } }
    }
    nloc = mine > 0u ? mine : 1u; nx = cnt > 0u ? cnt : 1u;
}
__device__ __forceinline__ void xcd_barrier(const XcdBarrier& b) {
    asm volatile("s_waitcnt vmcnt(0)" ::: "memory");
    __syncthreads();
    if (threadIdx.x == 0) {
        unsigned* bar = b.bar;
        __builtin_amdgcn_s_waitcnt(0);
        unsigned nloc = b.st[0], nx = b.st[1];
        if (nloc == 0u) { xcd_barrier_complete(bar, b.x, nloc, nx); b.st[0] = nloc; b.st[1] = nx; }
        const unsigned old = xb_add(&bar[XB_XSUB(b.x)], 1u);
        const unsigned gen = old / nloc;
        if (old + 1u == (gen + 1u) * nloc) {
            __builtin_amdgcn_fence(__ATOMIC_RELEASE, "agent");
            asm volatile("s_waitcnt vmcnt(0)" ::: "memory");
            const unsigned og = xb_add(&bar[XB_TOP], 1u);
            const unsigned tg = og / nx;
            if (og + 1u == (tg + 1u) * nx) xb_add(&bar[XB_TOPGEN], 1u);
            else XB_SPIN(xb_ld(&bar[XB_TOPGEN]) == tg, bar);
            __builtin_amdgcn_fence(__ATOMIC_ACQUIRE, "agent");
            xb_add(&bar[XB_XGEN(b.x)], 1u);
            asm volatile("s_waitcnt vmcnt(0)" ::: "memory");
        } else {
            XB_SPIN(xb_ld(&bar[XB_XGEN(b.x)]) == gen, bar);
            __builtin_amdgcn_fence(__ATOMIC_ACQUIRE, "agent");
            asm volatile("s_waitcnt vmcnt(0)" ::: "memory");
        }
    }
    __syncthreads();
}

#ifndef MOE_WGM
#define MOE_WGM 16
#endif
namespace pg8 {
constexpr int BM = 256, BK = 64, HALF = 128, HTB = HALF * BK * 2, STAGE_BYTES = 8 * HTB, NXCD = 8, WGM = 8;
__host__ __device__ __forceinline__ int lds_byte(int r, int c) { const int st = (r >> 4) * 2 + (c >> 5), rr = r & 15, cc = c & 31, ob = rr * 64 + cc * 2; return st * 1024 + (ob ^ (((ob >> 9) & 1) << 5)); }
__host__ __device__ __forceinline__ void stage_rc(int b, int& R, int& C) { const int st = b / 1024, sb = b % 1024, swz = sb ^ (((sb >> 9) & 1) << 5); R = (st >> 1) * 16 + swz / 64; C = (st & 1) * 32 + (swz % 64) / 2; }
__host__ __device__ __forceinline__ int perm32(int rho) { const int n = rho >> 4, i = rho & 15; return 8 * (i >> 2) + 4 * n + (i & 3); }
struct Unit { int pm, pn, k0, nt, slab; };

struct Sched {
    int nM, nN, nwg, G, c, ntot, S;
    const char* A; size_t a_tile, a_pn; const char* B; size_t b_tile, b_exp; const int* tile_e; const int* gather;
    __device__ __forceinline__ void init(int nM_, int nN_, int G_, int c_, int ntot_, bool split = false, int min_S = 2) {   nM = nM_; nN = nN_; nwg = nM * nN; G = G_; c = c_; ntot = ntot_; a_pn = 0; b_exp = 0; tile_e = nullptr; gather = nullptr;
        S = 1; if (split) { const int T = nwg % G; if (T > 0) { int s = G / T; if (s > 8) s = 8; if (s > ntot / 4) s = ntot / 4; if (s > 1 && s >= min_S) S = s; } } }
    template <int WG = WGM> __device__ __forceinline__ void map(long L, Unit& u) const {
        int wgid = (int)L; { const int q = nwg / NXCD, r = nwg % NXCD, xcd = wgid % NXCD, off = wgid / NXCD; wgid = (xcd < r ? xcd * (q + 1) : r * (q + 1) + (xcd - r) * q) + off; }
        const int nig = WG * nN, gid = wgid / nig, fm = gid * WG, gsz = (nM - fm) < WG ? (nM - fm) : WG;
        u.pm = fm + ((wgid % nig) % gsz); u.pn = (wgid % nig) / gsz; }
    template <int WG = WGM> __device__ __forceinline__ bool next(int i, Unit& u) const {
        if (S > 1) { const int R = nwg / G, T = nwg - R * G;
            if (i > R) return false;
            if (i == R) { if (c >= T * S) return false; const int tu = c % T, s = c / T; map<WG>((long)R * G + tu, u);
                const int base = (ntot / S) & ~1, rem2 = (ntot - base * S) >> 1; u.nt = base + (s < rem2 ? 2 : 0); u.k0 = s * base + 2 * (s < rem2 ? s : rem2); u.slab = s * T + tu; return true; } }
        const long L = (long)i * G + c; if (L >= nwg) return false;
        map<WG>(L, u); u.k0 = 0; u.nt = ntot; u.slab = -1; return true;
    }
    __device__ __forceinline__ const char* a_base(const Unit& u) const { return A + (size_t)u.pm * a_tile + (size_t)u.pn * a_pn + (size_t)u.k0 * 128; }
    __device__ __forceinline__ const char* b_base(const Unit& u) const { const int e = tile_e ? __builtin_amdgcn_readfirstlane(tile_e[u.pm]) : 0; return B + (size_t)e * b_exp + (size_t)u.pn * b_tile + (size_t)u.k0 * 128; }
};

constexpr int GATHER_LDS_OFF = 131072, GATHER_MAX_UNITS = 28;
template <class Epi, bool ALIGN_EPI = true, bool GATHER = false>
__device__ __forceinline__ void gemm_phase(LAS unsigned char* lds, const int K, const int lda, const Sched& S, const Epi& E) {
    int tid_ = threadIdx.x; asm volatile("" : "+v"(tid_));
    const int tid = tid_, wid = __builtin_amdgcn_readfirstlane(tid >> 6), lane = tid & 63, wr = wid >> 2, wc = wid & 3, fr = lane & 15, fq = lane >> 4;
    unsigned voffA[2][2], voffAn[2][2], voffB[2]; int aoff, boff;
#define PG8_LANECONST() do { int t_ = tid; asm volatile("" : "+v"(t_)); const int l_ = t_ & 63, fr_ = l_ & 15, fq_ = l_ >> 4; \
    _Pragma("unroll") for (int i = 0; i < 2; ++i) { int R, C; stage_rc(t_ * 16 + i * 8192, R, C); const int Rb = Epi::PERM ? ((R & ~31) + perm32(R & 31)) : R; \
        if (!GATHER) { voffA[0][i] = (unsigned)(R * lda + C) * 2u; voffA[1][i] = (unsigned)((R + HALF) * lda + C) * 2u; voffAn[0][i] = voffA[0][i]; voffAn[1][i] = voffA[1][i]; } voffB[i] = (unsigned)(Rb * K + C) * 2u; } \
    aoff = lds_byte(wr * 64 + fr_, fq_ * 8); boff = lds_byte(wc * 32 + fr_, fq_ * 8); } while (0)
    PG8_LANECONST();
#define PG8_GATHER_OFFS(dst, ui_) do { int t_ = tid; asm volatile("" : "+v"(t_)); _Pragma("unroll") for (int i = 0; i < 2; ++i) { int R, C; stage_rc(t_ * 16 + i * 8192, R, C); \
        const LAS int* gt_ = (const LAS int*)(lds + GATHER_LDS_OFF) + (ui_) * 256; dst[0][i] = (unsigned)(gt_[R] * lda + C) * 2u; dst[1][i] = (unsigned)(gt_[R + HALF] * lda + C) * 2u; } } while (0)
    if constexpr (GATHER) { Unit u_; for (int i = 0; i < GATHER_MAX_UNITS && S.template next<GATHER ? MOE_WGM : WGM>(i, u_); ++i) { if (tid < 256) ((LAS int*)(lds + GATHER_LDS_OFF))[i * 256 + tid] = S.gather[u_.pm * 256 + tid]; }
        asm volatile("s_waitcnt vmcnt(0) lgkmcnt(0)" ::: "memory"); __builtin_amdgcn_s_barrier(); PG8_GATHER_OFFS(voffA, 0); }
    const size_t kstep = (size_t)(BK * 2);
    const size_t hstepB = (size_t)HALF * K * 2;
    const unsigned ldsw = (unsigned)wid * 1024u;
#define PG8_SA(b, h) (((b) * 2 + (h)) * HTB)
#define PG8_SB(b, h) ((4 + (b) * 2 + (h)) * HTB)
#define PG8_STAGE(bufoff, gbase, voff) do { _Pragma("unroll") for (int _i = 0; _i < 2; ++_i) \
        __builtin_amdgcn_global_load_lds((const unsigned*)((const char*)(gbase) + (voff)[_i]), (LAS unsigned*)(lds + (bufoff) + ldsw + _i * 8192), 16, 0, 0); } while (0)
#define PG8_LDA(dst, b, h) do { _Pragma("unroll") for (int m = 0; m < 4; ++m) _Pragma("unroll") for (int k = 0; k < 2; ++k) dst[m][k] = *(const LAS bf16x8*)(lds + PG8_SA(b, h) + aoff + m * 2048 + k * 1024); } while (0)
#define PG8_LDB(dst, b, h) do { _Pragma("unroll") for (int n = 0; n < 2; ++n) _Pragma("unroll") for (int k = 0; k < 2; ++k) dst[n][k] = *(const LAS bf16x8*)(lds + PG8_SB(b, h) + boff + n * 2048 + k * 1024); } while (0)
#define PG8_MMA(ai, bj, At, Bt) do { __builtin_amdgcn_s_setprio(1); _Pragma("unroll") for (int m = 0; m < 4; ++m) _Pragma("unroll") for (int n = 0; n < 2; ++n) _Pragma("unroll") for (int k = 0; k < 2; ++k) \
        acc[ai][bj][m][n] = __builtin_amdgcn_mfma_f32_16x16x32_bf16(Bt[n][k], At[m][k], acc[ai][bj][m][n], 0, 0, 0); __builtin_amdgcn_s_setprio(0); } while (0)
#define PG8_WAIT_V(n) asm volatile("s_waitcnt vmcnt(" #n ")" ::: "memory")
#define PG8_WAIT_L(n) asm volatile("s_waitcnt lgkmcnt(" #n ")" ::: "memory")
#define PG8_BAR __builtin_amdgcn_s_barrier()
#define PG8_SCHED __builtin_amdgcn_sched_barrier(0)
    Unit cur, nxt; int ui = 0;
    if (!S.template next<GATHER ? MOE_WGM : WGM>(0, cur)) return;
    int nt = cur.nt;
    f32x4 acc[2][2][4][2];
#pragma unroll
    for (int a = 0; a < 2; ++a)
#pragma unroll
        for (int b = 0; b < 2; ++b)
#pragma unroll
            for (int m = 0; m < 4; ++m)
#pragma unroll
                for (int n = 0; n < 2; ++n) acc[a][b][m][n] = (f32x4){0.f, 0.f, 0.f, 0.f};
    bf16x8 At[4][2], B0[2][2], B1[2][2];
    const char* cA = S.a_base(cur); const char* cB = S.b_base(cur);
    PG8_STAGE(PG8_SB(0, 0), cB, voffB); PG8_STAGE(PG8_SB(0, 1), cB + hstepB, voffB); PG8_STAGE(PG8_SA(0, 0), cA, voffA[0]); PG8_STAGE(PG8_SA(0, 1), cA, voffA[1]);
    if (wr == 1) PG8_BAR;
    PG8_WAIT_V(2); PG8_BAR;
    PG8_STAGE(PG8_SB(1, 0), cB + kstep, voffB); PG8_STAGE(PG8_SA(1, 0), cA + kstep, voffA[0]); PG8_STAGE(PG8_SB(1, 1), cB + hstepB + kstep, voffB);
    PG8_WAIT_V(6); PG8_BAR;
    for (;;) {
        const bool has_next = S.template next<GATHER ? MOE_WGM : WGM>(ui + 1, nxt);
        const char* nA = has_next ? S.a_base(nxt) : cA; const char* nB = has_next ? S.b_base(nxt) : cB;
        if constexpr (GATHER) { if (has_next) PG8_GATHER_OFFS(voffAn, ui + 1); else { _Pragma("unroll") for (int h_ = 0; h_ < 2; ++h_) _Pragma("unroll") for (int i_ = 0; i_ < 2; ++i_) voffAn[h_][i_] = voffA[h_][i_]; } }
        for (int t = 0; t < nt; t += 2) {
            const bool last = (t == nt - 2);
            const char* a1 = cA + (size_t)(t + 1) * kstep;
            const char* a2 = last ? nA : cA + (size_t)(t + 2) * kstep; const char* b2 = last ? nB : cB + (size_t)(t + 2) * kstep;
            const char* a3 = a2 + kstep; const char* b3 = b2 + kstep;
            unsigned vs0[2], vs1[2];
            if constexpr (GATHER) { _Pragma("unroll") for (int i_ = 0; i_ < 2; ++i_) { vs0[i_] = last ? voffAn[0][i_] : voffA[0][i_]; vs1[i_] = last ? voffAn[1][i_] : voffA[1][i_]; } }
            else { _Pragma("unroll") for (int i_ = 0; i_ < 2; ++i_) { vs0[i_] = voffA[0][i_]; vs1[i_] = voffA[1][i_]; } }
            PG8_LDB(B0, 0, 0); PG8_LDB(B1, 0, 1); PG8_SCHED; PG8_LDA(At, 0, 0); PG8_STAGE(PG8_SA(1, 1), a1, voffA[1]);
            PG8_WAIT_V(8); PG8_WAIT_L(0); PG8_BAR; PG8_MMA(0, 0, At, B0); PG8_MMA(0, 1, At, B1); PG8_BAR; PG8_SCHED;
            PG8_LDA(At, 0, 1); PG8_STAGE(PG8_SB(0, 0), b2, voffB); PG8_STAGE(PG8_SB(0, 1), b2 + hstepB, voffB); PG8_STAGE(PG8_SA(0, 0), a2, vs0);
            PG8_WAIT_V(8); PG8_WAIT_L(0); PG8_BAR; PG8_MMA(1, 0, At, B0); PG8_MMA(1, 1, At, B1); PG8_BAR; PG8_SCHED;
            PG8_LDB(B0, 1, 0); PG8_LDB(B1, 1, 1); PG8_SCHED; PG8_LDA(At, 1, 0); PG8_STAGE(PG8_SA(0, 1), a2, vs1);
            PG8_WAIT_V(8); PG8_WAIT_L(0); PG8_BAR; PG8_MMA(0, 0, At, B0); PG8_MMA(0, 1, At, B1); PG8_BAR; PG8_SCHED;
            PG8_LDA(At, 1, 1); PG8_STAGE(PG8_SB(1, 0), b3, voffB); PG8_STAGE(PG8_SB(1, 1), b3 + hstepB, voffB); PG8_STAGE(PG8_SA(1, 0), a3, vs0);
            PG8_WAIT_V(8); PG8_WAIT_L(0); PG8_BAR; PG8_MMA(1, 0, At, B0); PG8_MMA(1, 1, At, B1); PG8_BAR; PG8_SCHED;
        }
        if constexpr (ALIGN_EPI) { if (wr == 0) PG8_BAR; }
        E(acc, cur, wr, wc, fr, fq);
        if (!has_next) break;
#pragma unroll
        for (int a = 0; a < 2; ++a)
#pragma unroll
            for (int b = 0; b < 2; ++b)
#pragma unroll
                for (int m = 0; m < 4; ++m)
#pragma unroll
                    for (int n = 0; n < 2; ++n) acc[a][b][m][n] = (f32x4){0.f, 0.f, 0.f, 0.f};
        cur = nxt; cA = nA; cB = nB; ++ui; nt = cur.nt;
        PG8_LANECONST();
        if constexpr (GATHER) PG8_GATHER_OFFS(voffA, ui);
        if constexpr (ALIGN_EPI) { if (wr == 1) PG8_BAR; }
    }
    PG8_WAIT_V(0);
    if constexpr (!ALIGN_EPI) { if (wr == 0) PG8_BAR; }
    PG8_BAR;
#undef PG8_LANECONST
#undef PG8_GATHER_OFFS
#undef PG8_SA
#undef PG8_SB
#undef PG8_STAGE
#undef PG8_LDA
#undef PG8_LDB
#undef PG8_MMA
#undef PG8_WAIT_V
#undef PG8_WAIT_L
#undef PG8_BAR
#undef PG8_SCHED
}
}

using pg8::Unit;
__device__ __forceinline__ int bidx_of_tile(int pm) { return pm < (NLAT / 256) ? (pm >> 4) : NB; }

struct EpiZ {
    static constexpr bool PERM = true;
    bf16_t* Z; float* SSQ;
    __device__ __forceinline__ void operator()(const f32x4 (&acc)[2][2][4][2], const Unit& u, int wr, int wc, int fr, int fq) const {
        const int row0 = u.pm * 256 + wr * 64 + fr, col0 = u.pn * 256 + wc * 32 + 8 * fq;
#pragma unroll
        for (int ai = 0; ai < 2; ++ai)
#pragma unroll
            for (int m = 0; m < 4; ++m) { const int row = row0 + ai * 128 + m * 16;
#pragma unroll
                for (int bj = 0; bj < 2; ++bj) { const f32x4 v0 = acc[ai][bj][m][0], v1 = acc[ai][bj][m][1];
                    u32x4 w; w.x = cvt_pk_bf16(v0[0], v0[1]); w.y = cvt_pk_bf16(v0[2], v0[3]); w.z = cvt_pk_bf16(v1[0], v1[1]); w.w = cvt_pk_bf16(v1[2], v1[3]);
                    *(GAS u32x4*)(Z + (size_t)row * ZW + col0 + bj * 128) = w;
                    float s = (v0[0] * v0[0] + v0[1] * v0[1]) + (v0[2] * v0[2] + v0[3] * v0[3]) + (v1[0] * v1[0] + v1[1] * v1[1]) + (v1[2] * v1[2] + v1[3] * v1[3]);
                    s += __shfl_xor(s, 16); s += __shfl_xor(s, 32);
                    if (fq == 0) ((GAS float*)SSQ)[(size_t)row * 24 + u.pn * 8 + bj * 4 + wc] = s; } }
    }
};
__device__ __forceinline__ float rstd_q_of(const float* SSQ, int row) { const GAS f32x4* p = (const GAS f32x4*)(SSQ + (size_t)row * 24); const f32x4 a = p[0], b = p[1], c = p[2];
    const float s = ((a[0] + a[1]) + (a[2] + a[3])) + ((b[0] + b[1]) + (b[2] + b[3])) + ((c[0] + c[1]) + (c[2] + c[3])); return rsqrtf(s * (1.0f / QLORA) + EPS); }
__device__ __forceinline__ float rstd_kv_of(const float* SSQ, int row) { const GAS f32x4* p = (const GAS f32x4*)(SSQ + (size_t)row * 24); const f32x4 a = p[3], b = p[4];
    const float s = ((a[0] + a[1]) + (a[2] + a[3])) + ((b[0] + b[1]) + (b[2] + b[3])); return rsqrtf(s * (1.0f / KVLORA) + EPS); }

struct EpiQ {
    static constexpr bool PERM = true;
    bf16_t* Q; const float* SSQ; const f32x2* ROPE_T;
    __device__ __forceinline__ void operator()(const f32x4 (&acc)[2][2][4][2], const Unit& u, int wr, int wc, int fr, int fq) const {
        const int row0 = u.pm * 256 + wr * 64 + fr, col0 = u.pn * 256 + wc * 32 + 8 * fq;
        const bool latent = u.pm < (NLAT / 256);
#pragma unroll
        for (int ai = 0; ai < 2; ++ai) {
            float rs4[4];
#pragma unroll
            for (int m = 0; m < 4; ++m) rs4[m] = rstd_q_of(SSQ, row0 + ai * 128 + m * 16) * ATT_C2;
#pragma unroll
            for (int m = 0; m < 4; ++m) { const int row = row0 + ai * 128 + m * 16; const float rs = rs4[m]; const int t = row & (SEQ - 1);
#pragma unroll
                for (int bj = 0; bj < 2; ++bj) { const int cb = col0 + bj * 128; const int d0 = cb % QKD;
                    float v[8];
#pragma unroll
                    for (int j = 0; j < 4; ++j) { v[j] = acc[ai][bj][m][0][j] * rs; v[4 + j] = acc[ai][bj][m][1][j] * rs; }
                    if (latent && d0 >= 64) {
                        const int dd = d0 - 64; const float pos = (float)((dd >> 4) == 0 ? (t >> 6) : (t & 63));
                        const float pr = pos * ((dd & 8) ? 0.01f : 1.0f) * 0.15915494309189535f;
                        const float r0 = pr, r1 = pr * 0.31622776601683794f, r2 = pr * 0.1f, r3 = pr * 0.031622776601683794f;
                        const float c0 = __builtin_amdgcn_cosf(r0), s0 = __builtin_amdgcn_sinf(r0), c1 = __builtin_amdgcn_cosf(r1), s1 = __builtin_amdgcn_sinf(r1);
                        const float c2 = __builtin_amdgcn_cosf(r2), s2 = __builtin_amdgcn_sinf(r2), c3 = __builtin_amdgcn_cosf(r3), s3 = __builtin_amdgcn_sinf(r3);
                        float x1, x2;
                        x1 = v[0]; x2 = v[1]; v[0] = x1 * c0 - x2 * s0; v[1] = x2 * c0 + x1 * s0;
                        x1 = v[2]; x2 = v[3]; v[2] = x1 * c1 - x2 * s1; v[3] = x2 * c1 + x1 * s1;
                        x1 = v[4]; x2 = v[5]; v[4] = x1 * c2 - x2 * s2; v[5] = x2 * c2 + x1 * s2;
                        x1 = v[6]; x2 = v[7]; v[6] = x1 * c3 - x2 * s3; v[7] = x2 * c3 + x1 * s3; }
                    u32x4 w; w.x = cvt_pk_bf16(v[0], v[1]); w.y = cvt_pk_bf16(v[2], v[3]); w.z = cvt_pk_bf16(v[4], v[5]); w.w = cvt_pk_bf16(v[6], v[7]);
                    *(GAS u32x4*)(Q + (size_t)row * (NHEAD * QKD) + cb) = w; } }
            asm volatile("" ::: "memory"); }
    }
};
struct EpiKV {
    static constexpr bool PERM = true;
    bf16_t* Kb; bf16_t* Vb; const float* SSQ;
    __device__ __forceinline__ void operator()(const f32x4 (&acc)[2][2][4][2], const Unit& u, int wr, int wc, int fr, int fq) const {
        const int row0 = u.pm * 256 + wr * 64 + fr;
#pragma unroll
        for (int ai = 0; ai < 2; ++ai) { float rs4[4];
#pragma unroll
            for (int m = 0; m < 4; ++m) rs4[m] = rstd_kv_of(SSQ, row0 + ai * 128 + m * 16);
#pragma unroll
            for (int m = 0; m < 4; ++m) { const int row = row0 + ai * 128 + m * 16; const float rs = rs4[m];
#pragma unroll
                for (int bj = 0; bj < 2; ++bj) { const int head = u.pn * 2 + bj; const int j0 = wc * 32 + 8 * fq;
                    const f32x4 v0 = acc[ai][bj][m][0] * rs, v1 = acc[ai][bj][m][1] * rs;
                    u32x4 w; w.x = cvt_pk_bf16(v0[0], v0[1]); w.y = cvt_pk_bf16(v0[2], v0[3]); w.z = cvt_pk_bf16(v1[0], v1[1]); w.w = cvt_pk_bf16(v1[2], v1[3]);
                    bf16_t* dst = ((j0 < 64) ? Kb : Vb) + (size_t)row * (NHEAD * VD) + head * VD + (j0 & 63);
                    *(u32x4*)dst = w; } }
            asm volatile("" ::: "memory"); }
    }
};
__device__ __forceinline__ f32x4 bf4_lo(const u32x4 w) { return (f32x4){__builtin_bit_cast(float, w.x << 16), __builtin_bit_cast(float, w.x & 0xffff0000u), __builtin_bit_cast(float, w.y << 16), __builtin_bit_cast(float, w.y & 0xffff0000u)}; }
__device__ __forceinline__ f32x4 bf4_hi(const u32x4 w) { return (f32x4){__builtin_bit_cast(float, w.z << 16), __builtin_bit_cast(float, w.z & 0xffff0000u), __builtin_bit_cast(float, w.w << 16), __builtin_bit_cast(float, w.w & 0xffff0000u)}; }
template <bool PS> struct EpiResidT {
    static constexpr bool PERM = true;
    bf16_t* X; const float* gate; const float* pscale; float* SLAB;
    __device__ __forceinline__ void operator()(const f32x4 (&acc)[2][2][4][2], const Unit& u, int wr, int wc, int fr, int fq) const {
        const int row0 = u.pm * 256 + wr * 64 + fr, col0 = u.pn * 256 + wc * 32 + 8 * fq;
        const float* g = gate + (size_t)bidx_of_tile(u.pm) * 6144;
        f32x4 gv[2][2];
#pragma unroll
        for (int bj = 0; bj < 2; ++bj)
#pragma unroll
            for (int n = 0; n < 2; ++n) { gv[bj][n] = *(const GAS f32x4*)(g + col0 + bj * 128 + n * 4); if (PS) gv[bj][n] = gv[bj][n] * *(const GAS f32x4*)(pscale + col0 + bj * 128 + n * 4); }
        if (u.slab >= 0) {
            float* sp = SLAB + ((size_t)u.slab * 256 + wr * 64 + fr) * 256 + wc * 32 + 8 * fq;
#pragma unroll
            for (int ai = 0; ai < 2; ++ai)
#pragma unroll
                for (int m = 0; m < 4; ++m)
#pragma unroll
                    for (int bj = 0; bj < 2; ++bj)
#pragma unroll
                        for (int n = 0; n < 2; ++n) *(GAS f32x4*)(sp + (size_t)(ai * 128 + m * 16) * 256 + bj * 128 + n * 4) = gv[bj][n] * acc[ai][bj][m][n];
            return; }
        u32x4 xv[2][4][2];
#pragma unroll
        for (int ai = 0; ai < 2; ++ai)
#pragma unroll
            for (int m = 0; m < 4; ++m)
#pragma unroll
                for (int bj = 0; bj < 2; ++bj) xv[ai][m][bj] = *(const GAS u32x4*)(X + (size_t)(row0 + ai * 128 + m * 16) * DM + col0 + bj * 128);
#pragma unroll
        for (int ai = 0; ai < 2; ++ai)
#pragma unroll
            for (int m = 0; m < 4; ++m)
#pragma unroll
                for (int bj = 0; bj < 2; ++bj) { const f32x4 a = bf4_lo(xv[ai][m][bj]) + gv[bj][0] * acc[ai][bj][m][0], b = bf4_hi(xv[ai][m][bj]) + gv[bj][1] * acc[ai][bj][m][1];
                    u32x4 w; w.x = cvt_pk_bf16(a[0], a[1]); w.y = cvt_pk_bf16(a[2], a[3]); w.z = cvt_pk_bf16(b[0], b[1]); w.w = cvt_pk_bf16(b[2], b[3]);
                    *(GAS u32x4*)(X + (size_t)(row0 + ai * 128 + m * 16) * DM + col0 + bj * 128) = w; }
    }
};
typedef EpiResidT<false> EpiResid;
struct EpiSwiGLU {
    static constexpr bool PERM = true;
    bf16_t* ACT;
    __device__ __forceinline__ void operator()(const f32x4 (&acc)[2][2][4][2], const Unit& u, int wr, int wc, int fr, int fq) const {
        const int row0 = u.pm * 256 + wr * 64 + fr, col0 = u.pn * 128 + wc * 32 + 8 * fq;
#pragma unroll
        for (int ai = 0; ai < 2; ++ai)
#pragma unroll
            for (int m = 0; m < 4; ++m) { float o[8];
#pragma unroll
                for (int n = 0; n < 2; ++n)
#pragma unroll
                    for (int j = 0; j < 4; ++j) o[n * 4 + j] = siluf_(acc[ai][0][m][n][j]) * acc[ai][1][m][n][j];
                u32x4 w; w.x = cvt_pk_bf16(o[0], o[1]); w.y = cvt_pk_bf16(o[2], o[3]); w.z = cvt_pk_bf16(o[4], o[5]); w.w = cvt_pk_bf16(o[6], o[7]);
                *(GAS u32x4*)(ACT + (size_t)(row0 + ai * 128 + m * 16) * FFN + col0) = w; }
    }
};
struct EpiGLU {
    static constexpr bool PERM = true;
    bf16_t* X; const float* gate;
    __device__ __forceinline__ void operator()(const f32x4 (&acc)[2][2][4][2], const Unit& u, int wr, int wc, int fr, int fq) const {
        const int row0 = u.pm * 256 + wr * 64 + fr, col0 = u.pn * 128 + wc * 32 + 8 * fq;
        const float* g = gate + (size_t)bidx_of_tile(u.pm) * 6144;
        f32x4 gv[2];
#pragma unroll
        for (int n = 0; n < 2; ++n) gv[n] = *(const GAS f32x4*)(g + col0 + n * 4);
        u32x4 xv[2][4];
#pragma unroll
        for (int ai = 0; ai < 2; ++ai)
#pragma unroll
            for (int m = 0; m < 4; ++m) xv[ai][m] = *(const GAS u32x4*)(X + (size_t)(row0 + ai * 128 + m * 16) * DM + col0);
#pragma unroll
        for (int ai = 0; ai < 2; ++ai)
#pragma unroll
            for (int m = 0; m < 4; ++m) { f32x4 o0, o1;
#pragma unroll
                for (int j = 0; j < 4; ++j) { o0[j] = acc[ai][0][m][0][j] * sigmoidf_(acc[ai][1][m][0][j]); o1[j] = acc[ai][0][m][1][j] * sigmoidf_(acc[ai][1][m][1][j]); }
                const f32x4 a = bf4_lo(xv[ai][m]) + gv[0] * o0, b = bf4_hi(xv[ai][m]) + gv[1] * o1;
                u32x4 w; w.x = cvt_pk_bf16(a[0], a[1]); w.y = cvt_pk_bf16(a[2], a[3]); w.z = cvt_pk_bf16(b[0], b[1]); w.w = cvt_pk_bf16(b[2], b[3]);
                *(GAS u32x4*)(X + (size_t)(row0 + ai * 128 + m * 16) * DM + col0) = w; }
    }
};
struct EpiBf16 {
    static constexpr bool PERM = true;
    bf16_t* O; int ldc; float* SLAB;
    __device__ __forceinline__ void operator()(const f32x4 (&acc)[2][2][4][2], const Unit& u, int wr, int wc, int fr, int fq) const {
        const int row0 = u.pm * 256 + wr * 64 + fr, col0 = u.pn * 256 + wc * 32 + 8 * fq;
        if (u.slab >= 0) { float* sp = SLAB + ((size_t)u.slab * 256 + wr * 64 + fr) * 256 + wc * 32 + 8 * fq;
#pragma unroll
            for (int ai = 0; ai < 2; ++ai)
#pragma unroll
                for (int m = 0; m < 4; ++m)
#pragma unroll
                    for (int bj = 0; bj < 2; ++bj) { float* q = sp + (size_t)(ai * 128 + m * 16) * 256 + bj * 128; *(GAS f32x4*)q = acc[ai][bj][m][0]; *(GAS f32x4*)(q + 4) = acc[ai][bj][m][1]; }
            return; }
#pragma unroll
        for (int ai = 0; ai < 2; ++ai)
#pragma unroll
            for (int m = 0; m < 4; ++m)
#pragma unroll
                for (int bj = 0; bj < 2; ++bj) { const f32x4 v0 = acc[ai][bj][m][0], v1 = acc[ai][bj][m][1];
                    u32x4 w; w.x = cvt_pk_bf16(v0[0], v0[1]); w.y = cvt_pk_bf16(v0[2], v0[3]); w.z = cvt_pk_bf16(v1[0], v1[1]); w.w = cvt_pk_bf16(v1[2], v1[3]);
                    *(GAS u32x4*)(O + (size_t)(row0 + ai * 128 + m * 16) * ldc + col0 + bj * 128) = w; }
    }
};

namespace att {
constexpr int KSLOT = 12288, VSLOT = 8192;
constexpr int NSK = 4, NSV = 4;
constexpr int LDS_K = 0, LDS_V = NSK * KSLOT, LDS_WS = LDS_V + NSV * VSLOT, LDS_OST = LDS_WS + 8 * 64 * 4, LDS_BYTES = LDS_OST + 8 * 4096;
static_assert(LDS_BYTES <= 131072, "attention LDS");
constexpr float C2 = 0.10206207261596577f * 1.4426950408889634f;
constexpr float THRL = 8.f;
#define SBAR() __builtin_amdgcn_sched_barrier(0)
__device__ __forceinline__ int crow(int r, int hi) { return (r & 3) + 8 * (r >> 2) + 4 * hi; }
__device__ __forceinline__ float max3f(float a, float b, float c) { return __builtin_fmaxf(__builtin_fmaxf(a, b), c); }
__device__ __forceinline__ float rowmax32(const f32x16& p0, const f32x16& p1) {
    float a = max3f(p0[0], p0[1], p1[0]), b = max3f(p0[2], p0[3], p1[1]); a = max3f(a, p1[2], p1[3]);
#pragma unroll
    for (int r = 4; r < 16; r += 4) { a = max3f(a, p0[r], p0[r + 1]); b = max3f(b, p0[r + 2], p0[r + 3]); a = max3f(a, p1[r], p1[r + 1]); b = max3f(b, p1[r + 2], p1[r + 3]); }
    float m = __builtin_fmaxf(a, b);
    auto rr = __builtin_amdgcn_permlane32_swap(__float_as_uint(m), __float_as_uint(m), false, false);
    return __builtin_fmaxf(__uint_as_float(rr[0]), __uint_as_float(rr[1]));
}
__device__ __forceinline__ void wait_bar(int n) {
    switch (n) {
        case 0: asm volatile("s_waitcnt vmcnt(0) lgkmcnt(0)\n\ts_barrier" ::: "memory"); break;
        case 1: asm volatile("s_waitcnt vmcnt(1) lgkmcnt(0)\n\ts_barrier" ::: "memory"); break;
        case 2: asm volatile("s_waitcnt vmcnt(2) lgkmcnt(0)\n\ts_barrier" ::: "memory"); break;
        case 3: asm volatile("s_waitcnt vmcnt(3) lgkmcnt(0)\n\ts_barrier" ::: "memory"); break;
        case 4: asm volatile("s_waitcnt vmcnt(4) lgkmcnt(0)\n\ts_barrier" ::: "memory"); break;
        case 5: asm volatile("s_waitcnt vmcnt(5) lgkmcnt(0)\n\ts_barrier" ::: "memory"); break;
        default: asm volatile("s_waitcnt vmcnt(6) lgkmcnt(0)\n\ts_barrier" ::: "memory"); break;
    }
}
#define WAITBAR(n) wait_bar(n)
__device__ __forceinline__ s16x4 vtr(const LAS unsigned char* p) { typedef short v4i16_t __attribute__((ext_vector_type(4))); return __builtin_bit_cast(s16x4, __builtin_amdgcn_ds_read_tr16_b64_v4i16((LAS v4i16_t*)p)); }

__device__ __forceinline__ void attn_unit(const bf16_t* __restrict__ Qb, const bf16_t* __restrict__ Kb, const bf16_t* __restrict__ Vb, bf16_t* __restrict__ Ob,
                                          const bf16_t* __restrict__ KRb, int qrow0, int kctx0, int klat0, int h, int NT, LAS unsigned char* lds) {
    int tid_ = threadIdx.x; asm volatile("" : "+v"(tid_));
    const int tid = tid_, lane = tid & 63, r32 = lane & 31, hi = lane >> 5; const int wid = __builtin_amdgcn_readfirstlane(tid >> 6);
    LAS float* wsf = (LAS float*)(lds + LDS_WS) + wid * 64;
    const int nk = wid < 4 ? 2 : 1;
    const bf16_t* ksrc = Kb + (size_t)lane * (NHEAD * VD) + h * VD + wid * 8;
    const bf16_t* krsrc = KRb + (size_t)lane * 32 + (wid & 3) * 8;
    const bf16_t* vsrc = Vb + (size_t)(16 * (wid & 3) + (lane >> 2)) * (NHEAD * VD) + h * VD + (wid >> 2) * 32 + (lane & 3) * 8;
#define KROW(t) ((t) < 4 ? kctx0 + (t) * 64 : klat0 + ((t) - 4) * 64)
#define DMA_K(t) do { const size_t kr_ = (size_t)KROW(t); LAS unsigned char* sl_ = lds + LDS_K + ((t) % NSK) * KSLOT; \
        __builtin_amdgcn_global_load_lds((const unsigned*)(ksrc + kr_ * (NHEAD * VD)), (LAS unsigned*)(sl_ + wid * 1024), 16, 0, 0); \
        if (wid < 4) __builtin_amdgcn_global_load_lds((const unsigned*)(krsrc + kr_ * 32), (LAS unsigned*)(sl_ + (wid + 8) * 1024), 16, 0, 0); } while (0)
#define DMA_V(t) do { const size_t ro_ = (size_t)KROW(t) * (NHEAD * VD); __builtin_amdgcn_global_load_lds((const unsigned*)(vsrc + ro_), (LAS unsigned*)(lds + LDS_V + ((t) % NSV) * VSLOT + wid * 1024), 16, 0, 0); } while (0)
    const LAS unsigned char* kp0 = lds + LDS_K + hi * 1024 + r32 * 16;
    const LAS unsigned char* vp0 = lds + LDS_V + ((lane >> 4) & 1) * 32 + (lane & 3) * 8 + (4 * hi + ((lane & 15) >> 2)) * 64;
    float mhat = 0.f; f32x16 o[3]; o[0] = f32x16{}; o[1] = f32x16{}; o[2] = f32x16{}; f32x16 negm = f32x16{}; asm volatile("" : "+v"(negm));
    const bf16x8 ones8 = {0x3F80, 0x3F80, 0x3F80, 0x3F80, 0x3F80, 0x3F80, 0x3F80, 0x3F80};
    bool resc = false;
    DMA_K(0); DMA_V(0); DMA_K(1); DMA_V(1); DMA_K(2);
    static_assert(NSK == 4 && NSV == 4, "prologue issues K0..K2, V0..V1");
    bf16x8 qr[6];
    { const bf16_t* Qw = Qb + (size_t)(qrow0 + wid * 32 + r32) * (NHEAD * QKD) + h * QKD + hi * 8;
#pragma unroll
      for (int d0 = 0; d0 < 6; ++d0) qr[d0] = *(const GAS bf16x8*)(Qw + d0 * 16); }
    asm volatile("" : "+v"(qr[0]), "+v"(qr[1]), "+v"(qr[2]), "+v"(qr[3]), "+v"(qr[4]), "+v"(qr[5]));
    WAITBAR(0);
    f32x16 pA0, pA1, pB0, pB1;
#define QKT(C0, C1, t) do { const LAS unsigned char* kb_ = kp0 + ((t) % NSK) * KSLOT; \
        _Pragma("unroll") for (int d0 = 0; d0 < 6; ++d0) { const bf16x8 b0 = *(const LAS bf16x8*)(kb_ + d0 * 2048), b1 = *(const LAS bf16x8*)(kb_ + d0 * 2048 + 512); \
            if (d0 == 0) { C0 = __builtin_amdgcn_mfma_f32_32x32x16_bf16(b0, qr[0], negm, 0, 0, 0); C1 = __builtin_amdgcn_mfma_f32_32x32x16_bf16(b1, qr[0], negm, 0, 0, 0); } \
            else { C0 = __builtin_amdgcn_mfma_f32_32x32x16_bf16(b0, qr[d0], C0, 0, 0, 0); C1 = __builtin_amdgcn_mfma_f32_32x32x16_bf16(b1, qr[d0], C1, 0, 0, 0); } } } while (0)
#define DECIDE(C0, C1, FIRST) do { float rm_ = rowmax32(C0, C1); resc = false; \
        if ((FIRST) || __builtin_expect(__any(rm_ > THRL), 0)) { const float dl_ = (FIRST) ? rm_ : __builtin_fmaxf(rm_, 0.f); mhat += dl_; \
            _Pragma("unroll") for (int r = 0; r < 16; ++r) { C0[r] -= dl_; C1[r] -= dl_; } \
            _Pragma("unroll") for (int r = 0; r < 16; ++r) negm[r] = -mhat; asm volatile("" : "+v"(negm)); \
            if (!(FIRST)) { const float f_ = __builtin_amdgcn_exp2f(-dl_); if (hi == 0) wsf[r32] = f_; resc = true; } } } while (0)
#define EXPS(C0, C1) do { _Pragma("unroll") for (int r = 0; r < 16; ++r) { C0[r] = __builtin_amdgcn_exp2f(C0[r]); C1[r] = __builtin_amdgcn_exp2f(C1[r]); } } while (0)
#define RESC() do { if (resc) { asm volatile("s_waitcnt lgkmcnt(0)" ::: "memory"); \
        _Pragma("unroll") for (int d_ = 0; d_ < 3; ++d_) _Pragma("unroll") for (int r = 0; r < 16; ++r) o[d_][r] *= wsf[crow(r, hi)]; } } while (0)
#define PV(P0, P1, t) do { u32x4 w0_, w1_, w2_, w3_; \
        w0_ = (u32x4){cvt_pk_bf16(P0[0], P0[1]), cvt_pk_bf16(P0[2], P0[3]), cvt_pk_bf16(P0[4], P0[5]), cvt_pk_bf16(P0[6], P0[7])}; \
        w1_ = (u32x4){cvt_pk_bf16(P0[8], P0[9]), cvt_pk_bf16(P0[10], P0[11]), cvt_pk_bf16(P0[12], P0[13]), cvt_pk_bf16(P0[14], P0[15])}; \
        w2_ = (u32x4){cvt_pk_bf16(P1[0], P1[1]), cvt_pk_bf16(P1[2], P1[3]), cvt_pk_bf16(P1[4], P1[5]), cvt_pk_bf16(P1[6], P1[7])}; \
        w3_ = (u32x4){cvt_pk_bf16(P1[8], P1[9]), cvt_pk_bf16(P1[10], P1[11]), cvt_pk_bf16(P1[12], P1[13]), cvt_pk_bf16(P1[14], P1[15])}; \
        const LAS unsigned char* vp_ = vp0 + ((t) % NSV) * VSLOT; \
        _Pragma("unroll") for (int d0 = 0; d0 < 2; ++d0) { \
            const s16x4 l0 = vtr(vp_ + d0 * 4096), h0 = vtr(vp_ + d0 * 4096 + 512), l1 = vtr(vp_ + d0 * 4096 + 1024), h1 = vtr(vp_ + d0 * 4096 + 1536); \
            const s16x4 l2 = vtr(vp_ + d0 * 4096 + 2048), h2 = vtr(vp_ + d0 * 4096 + 2560), l3 = vtr(vp_ + d0 * 4096 + 3072), h3 = vtr(vp_ + d0 * 4096 + 3584); \
            o[d0] = __builtin_amdgcn_mfma_f32_32x32x16_bf16(__builtin_bit_cast(bf16x8, w0_), (bf16x8){l0[0], l0[1], l0[2], l0[3], h0[0], h0[1], h0[2], h0[3]}, o[d0], 0, 0, 0); \
            o[d0] = __builtin_amdgcn_mfma_f32_32x32x16_bf16(__builtin_bit_cast(bf16x8, w1_), (bf16x8){l1[0], l1[1], l1[2], l1[3], h1[0], h1[1], h1[2], h1[3]}, o[d0], 0, 0, 0); \
            o[d0] = __builtin_amdgcn_mfma_f32_32x32x16_bf16(__builtin_bit_cast(bf16x8, w2_), (bf16x8){l2[0], l2[1], l2[2], l2[3], h2[0], h2[1], h2[2], h2[3]}, o[d0], 0, 0, 0); \
            o[d0] = __builtin_amdgcn_mfma_f32_32x32x16_bf16(__builtin_bit_cast(bf16x8, w3_), (bf16x8){l3[0], l3[1], l3[2], l3[3], h3[0], h3[1], h3[2], h3[3]}, o[d0], 0, 0, 0); } \
        o[2] = __builtin_amdgcn_mfma_f32_32x32x16_bf16(__builtin_bit_cast(bf16x8, w0_), ones8, o[2], 0, 0, 0); o[2] = __builtin_amdgcn_mfma_f32_32x32x16_bf16(__builtin_bit_cast(bf16x8, w1_), ones8, o[2], 0, 0, 0); \
        o[2] = __builtin_amdgcn_mfma_f32_32x32x16_bf16(__builtin_bit_cast(bf16x8, w2_), ones8, o[2], 0, 0, 0); o[2] = __builtin_amdgcn_mfma_f32_32x32x16_bf16(__builtin_bit_cast(bf16x8, w3_), ones8, o[2], 0, 0, 0); } while (0)
#define ISSUED(s_) (((s_) + NSK - 1 < NT ? nk : 0) + ((s_) + NSV - 2 < NT ? 1 : 0))
#define STEP_L(C0, C1, P0, P1, t, FIRST) do { \
        if ((t) + NSK - 1 < NT) DMA_K((t) + NSK - 1); if ((t) + NSV - 2 < NT) DMA_V((t) + NSV - 2); \
        QKT(C0, C1, t); \
        if (!(FIRST)) PV(P0, P1, (t) - 1); \
        DECIDE(C0, C1, FIRST); EXPS(C0, C1); \
        WAITBAR(ISSUED(t) + ((t) >= 1 ? ISSUED((t) - 1) : 0)); \
        RESC(); } while (0)
#define STEP_T(C0, C1, P0, P1, t, FIRST, SECOND) do { \
        if ((t) + NSK - 1 < NT) DMA_K((t) + NSK - 1); if ((t) + NSV - 2 < NT) DMA_V((t) + NSV - 2); \
        if (!(FIRST)) { DECIDE(P0, P1, SECOND); EXPS(P0, P1); RESC(); } \
        QKT(C0, C1, t); \
        if (!(FIRST)) PV(P0, P1, (t) - 1); \
        WAITBAR(ISSUED(t) + ((t) >= 1 ? ISSUED((t) - 1) : 0)); } while (0)
    if (wid < 4) {
        STEP_L(pA0, pA1, pB0, pB1, 0, true);
        STEP_L(pB0, pB1, pA0, pA1, 1, false);
        for (int t = 2; t + 1 < NT; t += 2) { STEP_L(pA0, pA1, pB0, pB1, t, false); STEP_L(pB0, pB1, pA0, pA1, t + 1, false); }
        PV(pB0, pB1, NT - 1);
    } else {
        STEP_T(pA0, pA1, pB0, pB1, 0, true, false);
        STEP_T(pB0, pB1, pA0, pA1, 1, false, true);
        for (int t = 2; t + 1 < NT; t += 2) { STEP_T(pA0, pA1, pB0, pB1, t, false, false); STEP_T(pB0, pB1, pA0, pA1, t + 1, false, false); }
        DECIDE(pB0, pB1, false); EXPS(pB0, pB1); RESC();
        PV(pB0, pB1, NT - 1);
    }
    float rli[16];
#pragma unroll
    for (int r = 0; r < 16; ++r) rli[r] = __builtin_amdgcn_rcpf(o[2][r]);
    { LAS bf16_t* stg = (LAS bf16_t*)(lds + LDS_OST) + wid * 2048;
#pragma unroll
      for (int r = 0; r < 16; ++r) { const int orow = crow(r, hi);
#pragma unroll
          for (int d0 = 0; d0 < 2; ++d0) stg[orow * 64 + d0 * 32 + r32] = (bf16_t)f2bf(o[d0][r] * rli[r]); }
      asm volatile("s_waitcnt lgkmcnt(0)" ::: "memory");
      bf16_t* Ow = Ob + (size_t)(qrow0 + wid * 32) * (NHEAD * VD) + h * VD;
#pragma unroll
      for (int i = 0; i < 4; ++i) { const int row = i * 8 + (lane >> 3), ch = lane & 7; const u32x4 v = *(const LAS u32x4*)(stg + row * 64 + ch * 8); *(GAS u32x4*)(Ow + (size_t)row * (NHEAD * VD) + ch * 8) = v; } }
    WAITBAR(0);
#undef KROW
#undef DMA_K
#undef DMA_V
#undef QKT
#undef DECIDE
#undef EXPS
#undef RESC
#undef PV
#undef STEP_L
#undef STEP_T
#undef ISSUED
}
#undef WAITBAR
#undef SBAR
}

#ifndef MOE_SPLIT
#define MOE_SPLIT false
#endif
constexpr size_t MiB = 1u << 20;
constexpr size_t WS_CTL = 0, CTL_ZERO_BYTES = 1 * MiB;
constexpr size_t CTL_BAR = 16384;
constexpr size_t CTL_MOD = 12 * MiB + 131072;
constexpr int MAX_LAUNCH_REGIONS = 64;
static_assert(CTL_BAR + (size_t)MAX_LAUNCH_REGIONS * 3456 * 4 <= CTL_ZERO_BYTES && CTL_MOD + 4 * 9 * 6144 * 4 <= 13 * MiB, "ctl");
constexpr size_t WS_ROPE = 1 * MiB;
constexpr size_t WS_S5FB = 2 * MiB;
constexpr size_t WS_S5MB = 6 * MiB;
constexpr size_t WS_S5EB = 8 * MiB;
constexpr size_t WS_S5L8 = 12 * MiB;
constexpr size_t WS_TOK = 13 * MiB;
constexpr size_t WS_S2R = 14 * MiB + 262144;
constexpr size_t WS_BLKCNT = 15 * MiB;
constexpr size_t WS_TILEE = WS_BLKCNT + 32768;
constexpr size_t WS_SSQ = 16 * MiB;
constexpr size_t WS_W = 20 * MiB;
constexpr size_t W_DQKV = 0;
constexpr size_t W_UQ = W_DQKV + (size_t)ZW * DM * 2;
constexpr size_t W_UKV = W_UQ + (size_t)1536 * QLORA * 2;
constexpr size_t W_O = W_UKV + (size_t)2048 * KVLORA * 2;
constexpr size_t W_MLA_SZ = W_O + (size_t)DM * DM * 2;
constexpr size_t W_GU_SZ = (size_t)2 * FFN * DM * 2, W_DN_SZ = (size_t)DM * FFN * 2, W_FFN_SZ = W_GU_SZ + W_DN_SZ;
constexpr size_t WO_MLA = 0, WO_FFN = WO_MLA + 2 * W_MLA_SZ, WO_MOE = WO_FFN + 2 * W_FFN_SZ, WO_GLU = WO_MOE + 16 * W_FFN_SZ, WO_POOL = WO_GLU + (size_t)2048 * DM * 2, WO_END = WO_POOL + (size_t)4 * 256 * 256 * 2;
constexpr size_t WS_X = WS_W + ((WO_END + MiB - 1) / MiB) * MiB;
constexpr size_t WS_H = WS_X + (size_t)MT * DM * 4;
constexpr size_t WS_BIG = WS_H + (size_t)MT * DM * 2;
constexpr size_t B_Z = 0, B_Q = B_Z + (size_t)MT * ZW * 2, B_K = B_Q + (size_t)MT * 1536 * 2, B_V = B_K + (size_t)MT * DM * 2, B_KR = B_V + (size_t)MT * DM * 2;
constexpr int MAXSLOT = 71680;
constexpr size_t B_XG = 0, B_ACTM = B_XG + (size_t)MAXSLOT * DM * 2, B_END = B_ACTM + (size_t)MAXSLOT * FFN * 2;
constexpr size_t B_G = 0, B_SIN = B_G + (size_t)MT * DM * 2;
constexpr size_t B_SLAB = (size_t)360 * MiB;
static_assert(B_KR + (size_t)MT * 64 <= B_SLAB && (size_t)MT * FFN * 2 <= B_SLAB && B_SLAB + (size_t)64 * MiB <= B_END && B_V + (size_t)MT * DM * 2 <= B_END && B_SIN + (size_t)64 * 2 * 8 * 544 * 128 * 2 <= B_END, "big");
constexpr size_t WS_SLAB2 = WS_BIG + B_END;
constexpr size_t WS_END = WS_SLAB2 + (size_t)64 * MiB;

struct Params { const float* in[33]; float* out; unsigned char* ws; int ph_lo, ph_hi, li, pad; };
struct Frame { LAS unsigned char* lds; int tid, lane, wave, blk, G, gw, NGW; unsigned char* ws; };
__device__ __forceinline__ Frame refresh(const Frame& F0) { Frame F = F0; int t = threadIdx.x; asm volatile("" : "+v"(t)); F.tid = t; F.lane = t & 63; return F; }
enum { I_X = 0, I_C, I_CTX, I_CCTX, I_N1G, I_N2G, I_ADAW, I_ADAB, I_FNG, I_WDQ, I_QNORM, I_WUQ, I_WDKV, I_KVNORM, I_WUKV, I_WO,
       I_S5ARE, I_S5AIM, I_S5LDT, I_S5BRE, I_S5BIM, I_S5CRE, I_S5CIM, I_S5D, I_S5GLU, I_POOLW, I_POOLS, I_FGU, I_FDN, I_MRW, I_MRB, I_MGU, I_MDN };

template <int SRC, bool COMB, int OUT, bool ROUTER, bool SLABS = false>
__device__ __forceinline__ void phase_rows(const Frame& F0, const Params& P, int nrows, const float* gain, const float* mod_shift  ,
                                           const float* mod_comb, int comb_rows, const float* w_router, const float* b_router, int route_rows, int slab_ntot = 0) {
    const Frame F = refresh(F0);
    LAS int* tailmap = (LAS int*)(F.lds + 1024); int slabS = 1, slabT = 0; const float* SLAB = (const float*)(F.ws + WS_BIG + B_SLAB);
    int mS = 1, mT = 0; const float* SLAB2 = (const float*)(F.ws + WS_SLAB2);
    if (COMB) { const int ntm_ = __builtin_amdgcn_readfirstlane(((const int*)(F.ws + WS_TILEE))[511]); pg8::Sched Sd; Sd.init(ntm_, 4, F.G, 0, FFN / 64, MOE_SPLIT, 8); mS = Sd.S; mT = Sd.nwg % F.G; const int Rr = Sd.nwg / F.G;
        for (int i = F.tid; i < ntm_ * 4; i += 512) tailmap[i] = 0;
        __syncthreads();
        if (mS > 1 && F.tid < mT) { pg8::Unit tu_; Sd.map((long)Rr * F.G + F.tid, tu_); tailmap[tu_.pm * 4 + tu_.pn] = F.tid + 1; }
        __syncthreads(); }
    if (SLABS) { pg8::Sched Sd; Sd.init(MT / 256, 4, F.G, 0, slab_ntot, true); slabS = Sd.S; slabT = Sd.nwg % F.G; const int Rr = Sd.nwg / F.G;
        for (int i = F.tid; i < (MT / 256) * 4; i += 512) tailmap[i] = 0;
        __syncthreads();
        if (slabS > 1 && F.tid < slabT) { pg8::Unit tu_; Sd.map((long)Rr * F.G + F.tid, tu_); tailmap[tu_.pm * 4 + tu_.pn] = F.tid + 1; }
        __syncthreads(); }
    bf16_t* X = (bf16_t*)(F.ws + WS_X); bf16_t* H = (bf16_t*)(F.ws + WS_H); const bf16_t* Y = (const bf16_t*)(F.ws + WS_BIG + B_XG);
    int* TOK = (int*)(F.ws + WS_TOK);
    LAS int* hist = (LAS int*)(F.lds);
    if (ROUTER) { if (F.tid < 8) hist[F.tid] = 0; __syncthreads(); }
    f32x4 gv[4];
#pragma unroll
    for (int j = 0; j < 4; ++j) gv[j] = *(const GAS f32x4*)(gain + 4 * F.lane + 256 * j);
    float wr[16][8];
    if (ROUTER) {
#pragma unroll
        for (int j = 0; j < 4; ++j)
#pragma unroll
            for (int q = 0; q < 4; ++q) { const int c = 4 * F.lane + 256 * j + q; const f32x4 wa = *(const GAS f32x4*)(w_router + (size_t)c * 8), wb = *(const GAS f32x4*)(w_router + (size_t)c * 8 + 4);
                wr[j * 4 + q][0] = wa[0]; wr[j * 4 + q][1] = wa[1]; wr[j * 4 + q][2] = wa[2]; wr[j * 4 + q][3] = wa[3]; wr[j * 4 + q][4] = wb[0]; wr[j * 4 + q][5] = wb[1]; wr[j * 4 + q][6] = wb[2]; wr[j * 4 + q][7] = wb[3]; } }
#define LOADROW(r_, dst, dstb, tkd) do { if (SRC == 1) { const float* src_ = (r_) < NLAT ? P.in[I_X] + (size_t)(r_) * DM : P.in[I_CTX] + (size_t)((r_) - NLAT) * DM; \
            _Pragma("unroll") for (int j = 0; j < 4; ++j) dst[j] = __builtin_nontemporal_load((const GAS f32x4*)(src_ + 4 * F.lane + 256 * j)); } \
        else { _Pragma("unroll") for (int j = 0; j < 4; ++j) dstb[j] = *(const GAS u32x2*)(X + (size_t)(r_) * DM + 4 * F.lane + 256 * j); } \
        if (COMB) { if ((r_) < comb_rows) tkd = *(const GAS u32x4*)(TOK + (size_t)(r_) * 8 + 4); } } while (0)
#define XSTORE(row_, j_, val_) do { u32x2 xw_; xw_.x = pk2((val_)[0], (val_)[1]); xw_.y = pk2((val_)[2], (val_)[3]); *(GAS u32x2*)(X + (size_t)(row_) * DM + 4 * F.lane + 256 * (j_)) = xw_; } while (0)
    f32x4 vn[4]; u32x2 vnb[4]; u32x4 tkn = {0u, 0u, 0u, 0u};
    if (F.gw < nrows) LOADROW(F.gw, vn, vnb, tkn);
    for (int row = F.gw; row < nrows; row += F.NGW) {
        const int bidx = row < NLAT ? (row >> 12) : NB;
        f32x4 v[4]; const u32x4 tkc = tkn;
#pragma unroll
        for (int j = 0; j < 4; ++j) { if (SRC == 1) v[j] = vn[j]; else v[j] = (f32x4){__builtin_bit_cast(float, vnb[j].x << 16), __builtin_bit_cast(float, vnb[j].x & 0xffff0000u), __builtin_bit_cast(float, vnb[j].y << 16), __builtin_bit_cast(float, vnb[j].y & 0xffff0000u)}; }
        u32x2 ya[4], yb[4]; float w0 = 0.f, w1 = 0.f;
        if (COMB) { if (row < comb_rows) { const int* tk = TOK + (size_t)row * 8; w0 = __int_as_float(tk[2]); w1 = __int_as_float(tk[3]); const int s0 = (int)tkc[2], s1 = (int)tkc[3];
#pragma unroll
            for (int j = 0; j < 4; ++j) { ya[j] = *(const GAS u32x2*)(Y + (size_t)s0 * DM + 4 * F.lane + 256 * j); yb[j] = *(const GAS u32x2*)(Y + (size_t)s1 * DM + 4 * F.lane + 256 * j); } } }
        { const int nrow = row + F.NGW; if (nrow < nrows) LOADROW(nrow, vn, vnb, tkn); }
        if (SLABS) { if (slabS > 1) { const int pm_ = row >> 8; bool any_ = false;
#pragma unroll
            for (int j = 0; j < 4; ++j) { const int tu_ = tailmap[pm_ * 4 + j]; if (tu_) { any_ = true; for (int s_ = 0; s_ < slabS; ++s_) v[j] = v[j] + *(const GAS f32x4*)(SLAB + ((size_t)(s_ * slabT + tu_ - 1) * 256 + (row & 255)) * 256 + 4 * F.lane); } }
            if (any_) {
#pragma unroll
                for (int j = 0; j < 4; ++j) XSTORE(row, j, v[j]); } } }
        if (SRC == 1) {
#pragma unroll
            for (int j = 0; j < 4; ++j) XSTORE(row, j, v[j]); }
        if (COMB) { if (row < comb_rows) { const int s0 = (int)tkc[2], s1 = (int)tkc[3];
#pragma unroll
            for (int j = 0; j < 4; ++j) { const u32x2 a = ya[j], b = yb[j];
                const f32x4 g5 = *(const GAS f32x4*)(mod_comb + (size_t)bidx * 6144 + 4 * F.lane + 256 * j);
                f32x4 ya4 = {bf2f(a.x & 0xffff), bf2f(a.x >> 16), bf2f(a.y & 0xffff), bf2f(a.y >> 16)}, yb4 = {bf2f(b.x & 0xffff), bf2f(b.x >> 16), bf2f(b.y & 0xffff), bf2f(b.y >> 16)};
                if (mS > 1) { const int ta = tailmap[(s0 >> 8) * 4 + j], tb = tailmap[(s1 >> 8) * 4 + j];
                    if (ta) { ya4 = (f32x4){0.f, 0.f, 0.f, 0.f}; for (int s_ = 0; s_ < mS; ++s_) ya4 = ya4 + *(const GAS f32x4*)(SLAB2 + ((size_t)(s_ * mT + ta - 1) * 256 + (s0 & 255)) * 256 + 4 * F.lane); }
                    if (tb) { yb4 = (f32x4){0.f, 0.f, 0.f, 0.f}; for (int s_ = 0; s_ < mS; ++s_) yb4 = yb4 + *(const GAS f32x4*)(SLAB2 + ((size_t)(s_ * mT + tb - 1) * 256 + (s1 & 255)) * 256 + 4 * F.lane); } }
                f32x4 y = ya4 * w0 + yb4 * w1;
                v[j] = v[j] + g5 * y; if (OUT != 2) XSTORE(row, j, v[j]); } } }
        if (OUT == 2 && row >= NLAT) continue;
        float s = 0.f;
#pragma unroll
        for (int j = 0; j < 4; ++j) s += (v[j][0] * v[j][0] + v[j][1] * v[j][1]) + (v[j][2] * v[j][2] + v[j][3] * v[j][3]);
        const float rstd = rsqrtf(wave_sum_dpp(s) * (1.0f / DM) + EPS);
        if (OUT == 2) {
#pragma unroll
            for (int j = 0; j < 4; ++j) __builtin_nontemporal_store(v[j] * rstd * gv[j], (GAS f32x4*)(P.out + (size_t)row * DM + 4 * F.lane + 256 * j));
            continue; }
        f32x4 hh[4];
#pragma unroll
        for (int j = 0; j < 4; ++j) { const f32x4 sh = *(const GAS f32x4*)(mod_shift + (size_t)bidx * 6144 + 4 * F.lane + 256 * j), sc = *(const GAS f32x4*)(mod_shift + (size_t)bidx * 6144 + 1024 + 4 * F.lane + 256 * j);
            hh[j] = (v[j] * rstd * gv[j]) * (sc + 1.0f) + sh; }
#pragma unroll
        for (int j = 0; j < 4; ++j) { u32x2 w; w.x = pk2(hh[j][0], hh[j][1]); w.y = pk2(hh[j][2], hh[j][3]);
            if (OUT == 0) *(GAS u32x2*)(H + (size_t)row * DM + 4 * F.lane + 256 * j) = w;
            else { const int grp = (F.lane >> 2) + 16 * j; *(GAS u32x2*)(H + ((size_t)grp * MT + row) * 16 + 4 * (F.lane & 3)) = w; } }
        if (ROUTER) { if (row < route_rows) {
            float pl[8];
#pragma unroll
            for (int e = 0; e < 8; ++e) pl[e] = 0.f;
#pragma unroll
            for (int j = 0; j < 4; ++j)
#pragma unroll
                for (int q = 0; q < 4; ++q) { const float hv = hh[j][q];
#pragma unroll
                    for (int e = 0; e < 8; ++e) pl[e] += hv * wr[j * 4 + q][e]; }
            float lg[8];
            { const bool b2 = (F.lane & 4) != 0, b1 = (F.lane & 2) != 0, b0 = (F.lane & 1) != 0; float q4[4], r2[2];
#pragma unroll
              for (int i = 0; i < 4; ++i) { const float keep = b2 ? pl[4 + i] : pl[i], send = b2 ? pl[i] : pl[4 + i]; q4[i] = keep + __shfl_xor(send, 4); }
#pragma unroll
              for (int i = 0; i < 2; ++i) { const float keep = b1 ? q4[2 + i] : q4[i], send = b1 ? q4[i] : q4[2 + i]; r2[i] = keep + __shfl_xor(send, 2); }
              float tot = (b0 ? r2[1] : r2[0]) + __shfl_xor(b0 ? r2[0] : r2[1], 1);
              tot += __shfl_xor(tot, 8); tot += __shfl_xor(tot, 16); tot += __shfl_xor(tot, 32);
#pragma unroll
              for (int e = 0; e < 8; ++e) lg[e] = __builtin_bit_cast(float, __builtin_amdgcn_readlane(__builtin_bit_cast(int, tot), e)) + b_router[e]; }
            int e0 = 0; float v0 = lg[0];
#pragma unroll
            for (int e = 1; e < 8; ++e) if (lg[e] > v0) { v0 = lg[e]; e0 = e; }
            int e1 = -1; float v1 = -3.0e38f;
#pragma unroll
            for (int e = 0; e < 8; ++e) if (e != e0 && lg[e] > v1) { v1 = lg[e]; e1 = e; }
            const float ex = __expf(v1 - v0); const float w0 = __builtin_amdgcn_rcpf(1.0f + ex), w1 = ex * w0;
            if (F.lane == 0) { const int l0 = __hip_atomic_fetch_add(hist + e0, 1, __ATOMIC_RELAXED, __HIP_MEMORY_SCOPE_WORKGROUP), l1 = __hip_atomic_fetch_add(hist + e1, 1, __ATOMIC_RELAXED, __HIP_MEMORY_SCOPE_WORKGROUP);
                int* tk = TOK + (size_t)row * 8; tk[0] = e0; tk[1] = e1; tk[2] = __float_as_int(w0); tk[3] = __float_as_int(w1); tk[4] = l0; tk[5] = l1; } } }
    }
#undef LOADROW
#undef XSTORE
    if (ROUTER) { __syncthreads(); if (F.tid < 8) ((int*)(F.ws + WS_BLKCNT))[F.blk * 8 + F.tid] = hist[F.tid]; __syncthreads(); }
}

__device__ __forceinline__ void phase_scatter(const Frame& F0, int nrows) {
    const Frame F = refresh(F0);
    const int* BC = (const int*)(F.ws + WS_BLKCNT); int* TOK = (int*)(F.ws + WS_TOK); int* TILEE = (int*)(F.ws + WS_TILEE);
    LAS int* sh = (LAS int*)(F.lds);
    for (int i = F.tid; i < F.G * 8; i += 512) sh[64 + i] = BC[i];
    __syncthreads();
    if (F.tid < 8) { sh[32 + F.tid] = 0; sh[F.tid] = 0; }
    __syncthreads();
    for (int i = F.tid; i < F.G * 8; i += 512) { const int c = sh[64 + i], e = i & 7, b = i >> 3; if (c) { __hip_atomic_fetch_add(sh + 32 + e, c, __ATOMIC_RELAXED, __HIP_MEMORY_SCOPE_WORKGROUP); if (b < F.blk) __hip_atomic_fetch_add(sh + e, c, __ATOMIC_RELAXED, __HIP_MEMORY_SCOPE_WORKGROUP); } }
    __syncthreads();
    if (F.tid == 0) { int off = 0; for (int e = 0; e < 8; ++e) { sh[8 + e] = off; off += ((sh[32 + e] + 255) >> 8) << 8; } sh[16] = off; }
    __syncthreads();
    if (F.blk == 0) { const int ntm = sh[16] >> 8; for (int t = F.tid; t < 511; t += 512) { int e = 7; for (int q = 0; q < 8; ++q) if (t * 256 >= sh[8 + q] && t * 256 < sh[9 + q]) e = q; TILEE[t] = e; } if (F.tid == 0) TILEE[511] = ntm; }
    int* S2R = (int*)(F.ws + WS_S2R);
    if (F.blk == 1 % F.G) { for (int e = 0; e < 8; ++e) { const int lo = sh[8 + e] + sh[32 + e], hi = sh[9 + e]; for (int s = lo + F.tid; s < hi; s += 512) S2R[s] = 0; } }
    { const int row = F.gw + F.lane * F.NGW;
      if (F.lane * F.NGW + F.gw < nrows) { int* tk = TOK + (size_t)row * 8; const u32x4 t0 = *(const u32x4*)tk, t1 = *(const GAS u32x4*)(tk + 4); const int e0 = (int)t0[0], e1 = (int)t0[1];
          const int s0 = sh[8 + e0] + sh[e0] + (int)t1[0], s1 = sh[8 + e1] + sh[e1] + (int)t1[1]; tk[6] = s0; tk[7] = s1; S2R[s0] = row; S2R[s1] = row; } }
    __syncthreads();
}

__device__ __forceinline__ void phase_pool(const Frame& F0) {
    const Frame F = refresh(F0);
    const bf16_t* H = (const bf16_t*)(F.ws + WS_H); bf16_t* PIN = (bf16_t*)(F.ws + WS_BIG);
    LAS unsigned char* tile = F.lds;
    u32x4 nx[12];
#define POOL_GEOM(tl_, r0_, base_, L_, t0_) const int r0_ = (tl_) * 32; int base_, L_; if (r0_ < NLAT) { base_ = r0_ & ~(SEQ - 1); L_ = SEQ; } else { base_ = NLAT + ((r0_ - NLAT) & ~(CTX - 1)); L_ = CTX; } const int t0_ = r0_ - base_
#define POOL_LOAD(tl_) do { POOL_GEOM(tl_, r0n, basen, Ln, t0n); _Pragma("unroll") for (int k = 0; k < 12; ++k) { const int i = F.tid + 512 * k, lr = i >> 7, c = i & 127, t = t0n - 8 + lr; \
            if (t >= 0 && t < Ln) nx[k] = *(const GAS u32x4*)(H + (size_t)(basen + t) * DM + c * 8); } } while (0)
    if (F.blk < MT / 32) POOL_LOAD(F.blk);
    for (int tl = F.blk; tl < MT / 32; tl += F.G) {
        POOL_GEOM(tl, r0, base, L, t0);
        __syncthreads();
#pragma unroll
        for (int k = 0; k < 12; ++k) { const int i = F.tid + 512 * k, lr = i >> 7, c = i & 127, t = t0 - 8 + lr; if (t >= 0 && t < L) *(LAS u32x4*)(tile + lr * 2048 + c * 16) = nx[k]; }
        __syncthreads();
        if (tl + F.G < MT / 32) POOL_LOAD(tl + F.G);
        { const int c8 = F.tid & 127, rq = F.tid >> 7, w = 2 << (c8 >> 5), hw = w >> 1;
#pragma unroll 2
          for (int rr = 0; rr < 8; ++rr) { const int lr = rq * 8 + rr, t = t0 + lr;
              int lo = t - hw; if (lo < 0) lo = 0; int hi = t + w - hw; if (hi > L) hi = L;
              float s[8];
#pragma unroll
              for (int q = 0; q < 8; ++q) s[q] = 0.f;
              for (int r = lo; r < hi; ++r) { const u32x4 a = *(const LAS u32x4*)(tile + (r - t0 + 8) * 2048 + c8 * 16);
                  s[0] += bf2f(a.x & 0xffff); s[1] += bf2f(a.x >> 16); s[2] += bf2f(a.y & 0xffff); s[3] += bf2f(a.y >> 16); s[4] += bf2f(a.z & 0xffff); s[5] += bf2f(a.z >> 16); s[6] += bf2f(a.w & 0xffff); s[7] += bf2f(a.w >> 16); }
              const float inv = __builtin_amdgcn_rcpf((float)(hi - lo));
              const u32x4 a = *(const LAS u32x4*)(tile + (lr + 8) * 2048 + c8 * 16);
              u32x4 o; o.x = pk2(s[0] * inv - bf2f(a.x & 0xffff), s[1] * inv - bf2f(a.x >> 16)); o.y = pk2(s[2] * inv - bf2f(a.y & 0xffff), s[3] * inv - bf2f(a.y >> 16));
              o.z = pk2(s[4] * inv - bf2f(a.z & 0xffff), s[5] * inv - bf2f(a.z >> 16)); o.w = pk2(s[6] * inv - bf2f(a.w & 0xffff), s[7] * inv - bf2f(a.w >> 16));
              *(GAS u32x4*)(PIN + (size_t)(r0 + lr) * DM + c8 * 8) = o; } }
    }
#undef POOL_GEOM
#undef POOL_LOAD
    __syncthreads();
}

__device__ __forceinline__ void phase_krope(const Frame& F0, int nrows) {
    const Frame F = refresh(F0);
    const bf16_t* Z = (const bf16_t*)(F.ws + WS_BIG + B_Z); bf16_t* KR = (bf16_t*)(F.ws + WS_BIG + B_KR); const f32x2* RT = (const f32x2*)(F.ws + WS_ROPE);
    for (int it = F.blk * 512 + F.tid; it < nrows * 4; it += F.G * 512) { const int row = it >> 2, part = it & 3;
        const u32x4 a = *(const GAS u32x4*)(Z + (size_t)row * ZW + 640 + part * 8);
        float v[8] = {bf2f(a.x & 0xffff), bf2f(a.x >> 16), bf2f(a.y & 0xffff), bf2f(a.y >> 16), bf2f(a.z & 0xffff), bf2f(a.z >> 16), bf2f(a.w & 0xffff), bf2f(a.w >> 16)};
        if (row < NLAT) { const f32x4* cs = (const f32x4*)(RT + (size_t)(row & (SEQ - 1)) * 16 + part * 4); const f32x4 c01 = cs[0], c23 = cs[1]; float x1, x2;
            x1 = v[0]; x2 = v[1]; v[0] = x1 * c01[0] - x2 * c01[1]; v[1] = x2 * c01[0] + x1 * c01[1];
            x1 = v[2]; x2 = v[3]; v[2] = x1 * c01[2] - x2 * c01[3]; v[3] = x2 * c01[2] + x1 * c01[3];
            x1 = v[4]; x2 = v[5]; v[4] = x1 * c23[0] - x2 * c23[1]; v[5] = x2 * c23[0] + x1 * c23[1];
            x1 = v[6]; x2 = v[7]; v[6] = x1 * c23[2] - x2 * c23[3]; v[7] = x2 * c23[2] + x1 * c23[3]; }
        u32x4 w; w.x = pk2(v[0], v[1]); w.y = pk2(v[2], v[3]); w.z = pk2(v[4], v[5]); w.w = pk2(v[6], v[7]);
        *(GAS u32x4*)(KR + (size_t)row * 32 + part * 8) = w;
    }
}

struct TJob { const float* W; int K, N; bf16_t* WT; int NR, map; const float* ks; };
__device__ __forceinline__ int rope_orig(int d) { return (d & 16) + ((d & 1) << 3) + ((d & 15) >> 1); }
__device__ __forceinline__ int tjob_srccol(const TJob& J, int n) {
    switch (J.map) {
        case 1: { const int pn = n >> 8, r = n & 255; return r < 128 ? 128 * pn + r : (J.N >> 1) + 128 * pn + (r - 128); }
        case 2: return n < 256 ? n : (n < 288 ? 256 + rope_orig(n - 256) : -1);
        case 3: { const int h = n / QKD, d = n % QKD; return d < 64 ? n : h * QKD + 64 + rope_orig(d - 64); }
        default: return n;
    }
}
constexpr int N_TJOBS = 51;
__device__ __forceinline__ TJob get_tjob(int j, const Params& P, unsigned char* ws) {
    TJob J; J.ks = nullptr; J.map = 0; unsigned char* wb = ws + WS_W;
    if (j < 8) { const int l = j >> 2, kind = j & 3; unsigned char* m = wb + WO_MLA + (size_t)l * W_MLA_SZ;
        if (kind == 0) { J.W = P.in[I_WDQ] + (size_t)l * DM * QLORA; J.K = DM; J.N = QLORA; J.WT = (bf16_t*)(m + W_DQKV); J.NR = QLORA; }
        else if (kind == 1) { J.W = P.in[I_WDKV] + (size_t)l * DM * 288; J.K = DM; J.N = 288; J.WT = (bf16_t*)(m + W_DQKV) + (size_t)QLORA * DM; J.NR = 384; J.map = 2; }
        else if (kind == 2) { J.W = P.in[I_WUQ] + (size_t)l * QLORA * 1536; J.K = QLORA; J.N = 1536; J.WT = (bf16_t*)(m + W_UQ); J.NR = 1536; J.map = 3; J.ks = P.in[I_QNORM] + l * QLORA; }
        else { J.W = P.in[I_WUKV] + (size_t)l * KVLORA * 2048; J.K = KVLORA; J.N = 2048; J.WT = (bf16_t*)(m + W_UKV); J.NR = 2048; J.ks = P.in[I_KVNORM] + l * KVLORA; }
    } else if (j < 10) { const int l = j - 8; J.W = P.in[I_WO] + (size_t)l * DM * DM; J.K = DM; J.N = DM; J.WT = (bf16_t*)(wb + WO_MLA + (size_t)l * W_MLA_SZ + W_O); J.NR = DM; }
    else if (j < 14) { const int k = (j - 10) >> 1, dn = (j - 10) & 1; unsigned char* m = wb + WO_FFN + (size_t)k * W_FFN_SZ;
        if (!dn) { J.W = P.in[I_FGU] + (size_t)k * DM * 2 * FFN; J.K = DM; J.N = 2 * FFN; J.WT = (bf16_t*)m; J.NR = 2 * FFN; J.map = 1; }
        else { J.W = P.in[I_FDN] + (size_t)k * FFN * DM; J.K = FFN; J.N = DM; J.WT = (bf16_t*)(m + W_GU_SZ); J.NR = DM; } }
    else if (j < 46) { const int ke = (j - 14) >> 1, dn = (j - 14) & 1; unsigned char* m = wb + WO_MOE + (size_t)ke * W_FFN_SZ;
        if (!dn) { J.W = P.in[I_MGU] + (size_t)ke * DM * 2 * FFN; J.K = DM; J.N = 2 * FFN; J.WT = (bf16_t*)m; J.NR = 2 * FFN; J.map = 1; }
        else { J.W = P.in[I_MDN] + (size_t)ke * FFN * DM; J.K = FFN; J.N = DM; J.WT = (bf16_t*)(m + W_GU_SZ); J.NR = DM; } }
    else if (j == 46) { J.W = P.in[I_S5GLU]; J.K = DM; J.N = 2048; J.WT = (bf16_t*)(wb + WO_GLU); J.NR = 2048; J.map = 1; }
    else { const int g = j - 47; J.W = P.in[I_POOLW] + (size_t)g * 65536; J.K = 256; J.N = 256; J.WT = (bf16_t*)(wb + WO_POOL + (size_t)g * 131072); J.NR = 256; }
    return J;
}
__device__ __forceinline__ void transpose_item(const TJob& J, LAS float* scr, int item, int lane) {
    const int nblk = J.NR / 32, kb = item / nblk, nb = item % nblk, k0 = 64 * kb, n0 = 32 * nb;
    const int sc = tjob_srccol(J, n0 + (lane & 31));
#pragma unroll 8
    for (int i = 0; i < 32; ++i) { const int kk = 2 * i + (lane >> 5); float v = sc >= 0 ? J.W[(size_t)(k0 + kk) * J.N + sc] : 0.f; if (J.ks) v *= J.ks[k0 + kk]; scr[kk * 33 + (lane & 31)] = v; }
    asm volatile("s_waitcnt lgkmcnt(0)" ::: "memory");
    const int c = lane & 7;
#pragma unroll
    for (int jj = 0; jj < 4; ++jj) { const int n = (lane >> 3) + 8 * jj; const LAS float* s = scr + (8 * c) * 33 + n;
        u32x4 o; o.x = pk2(s[0 * 33], s[1 * 33]); o.y = pk2(s[2 * 33], s[3 * 33]); o.z = pk2(s[4 * 33], s[5 * 33]); o.w = pk2(s[6 * 33], s[7 * 33]);
        *(GAS u32x4*)(J.WT + (size_t)(n0 + n) * J.K + k0 + 8 * c) = o; }
    asm volatile("s_waitcnt lgkmcnt(0)" ::: "memory");
}
struct TLoad { f32x4 v[16]; };
__device__ __forceinline__ void tfast_load(const TJob& J, int item, int lane, TLoad& L) {
    const int nblk = J.NR / 64, kb = item / nblk, nb = item % nblk, k0 = 64 * kb, n0 = 64 * nb;
    const int sc = tjob_srccol(J, n0) + 4 * (lane & 15);
    const float* src = J.W + (size_t)(k0 + (lane >> 4)) * J.N + sc;
#pragma unroll
    for (int i = 0; i < 16; ++i) L.v[i] = __builtin_nontemporal_load((const GAS f32x4*)(src + (size_t)(4 * i) * J.N));
}
__device__ __forceinline__ void tfast_store(const TJob& J, int item, int lane, const TLoad& L, LAS unsigned char* tile) {
    const int nblk = J.NR / 64, kb = item / nblk, nb = item % nblk, k0 = 64 * kb, n0 = 64 * nb;
#pragma unroll
    for (int i = 0; i < 16; ++i) { const int kr = 4 * i + (lane >> 4); f32x4 v = L.v[i]; if (J.ks) v = v * J.ks[k0 + kr];
        u32x2 w; w.x = cvt_pk_bf16(v[0], v[1]); w.y = cvt_pk_bf16(v[2], v[3]); *(LAS u32x2*)(tile + kr * 192 + 8 * (lane & 15)) = w; }
    asm volatile("s_waitcnt lgkmcnt(0)" ::: "memory");
    const int g = lane >> 4, i16 = lane & 15, q = (lane >> 2) & 3, p = lane & 3;
#pragma unroll
    for (int nbk = 0; nbk < 4; ++nbk)
#pragma unroll
        for (int half = 0; half < 2; ++half) { const int c = 4 * half + g;
            const unsigned a0 = (unsigned)(uintptr_t)(tile + (8 * c + q) * 192 + (16 * nbk + 4 * p) * 2);
            s16x4 lo, hi; asm volatile("ds_read_b64_tr_b16 %0, %1" : "=&v"(lo) : "v"(a0) : "memory"); asm volatile("ds_read_b64_tr_b16 %0, %1 offset:768" : "=&v"(hi) : "v"(a0) : "memory");
            asm volatile("s_waitcnt lgkmcnt(0)" : "+v"(lo), "+v"(hi) :: "memory");
            const bf16x8 o = (bf16x8){lo[0], lo[1], lo[2], lo[3], hi[0], hi[1], hi[2], hi[3]};
            *(GAS bf16x8*)(J.WT + (size_t)(n0 + 16 * nbk + i16) * J.K + k0 + 8 * c) = o; }
    asm volatile("s_waitcnt lgkmcnt(0)" ::: "memory");
}
__device__ __forceinline__ void adaln_task(const Params& P, float* MOD, const LAS float* ST, int task, int lane) {
    const int cbk = task % 192, l = task / 192, kq = lane >> 3, cq = lane & 7;
    const int col = cbk * 32 + 4 * cq, k0 = kq * 128;
    const float* W = P.in[I_ADAW] + (size_t)l * DM * 6144 + col;
    f32x4 acc[9];
#pragma unroll
    for (int r = 0; r < 9; ++r) acc[r] = (f32x4){0.f, 0.f, 0.f, 0.f};
#pragma unroll 8
    for (int kk = 0; kk < 128; ++kk) { const int k = k0 + kk; const f32x4 w = *(const GAS f32x4*)(W + (size_t)k * 6144);
#pragma unroll
        for (int r = 0; r < 9; ++r) acc[r] = acc[r] + w * ST[r * 1024 + k]; }
    const f32x4 b = *(const GAS f32x4*)(P.in[I_ADAB] + (size_t)l * 6144 + col);
#pragma unroll
    for (int r = 0; r < 9; ++r) { f32x4 v = acc[r];
#pragma unroll
        for (int q = 0; q < 4; ++q) { float x = v[q]; x += __shfl_xor(x, 8); x += __shfl_xor(x, 16); x += __shfl_xor(x, 32); v[q] = x; }
        if (kq == 0) *(GAS f32x4*)(MOD + ((size_t)l * 9 + r) * 6144 + col) = v + b; }
}
__device__ __forceinline__ void s5_precompute(const Frame& F, const Params& P, int g) {
    LAS float* LP = (LAS float*)F.lds;
    LAS float* BB = LP + 2 * 9 * 64 * 2;
    LAS float* CC = BB + 2 * 64 * 16 * 2;
    LAS float* KT = CC + 2 * 16 * 64 * 2;
    __syncthreads();
    if (F.tid < 128) { const int dir = F.tid >> 6, p = F.tid & 63; const int ix = (dir * 64 + g) * 64 + p;
        const float are = fminf(P.in[I_S5ARE][ix], -1e-4f), aim = P.in[I_S5AIM][ix], dt = expf(P.in[I_S5LDT][dir * 64 + g]);
        const float lr = are * dt, li = aim * dt, mag = expf(lr), br = mag * cosf(li), bi = mag * sinf(li);
        float pr = 1.f, pi = 0.f;
        for (int k = 0; k <= 8; ++k) { LP[((dir * 9 + k) * 64 + p) * 2] = pr; LP[((dir * 9 + k) * 64 + p) * 2 + 1] = pi; const float nr = pr * br - pi * bi, ni = pr * bi + pi * br; pr = nr; pi = ni; }
        const float xr = br - 1.f, xi = bi, den = are * are + aim * aim; const float cr = (xr * are + xi * aim) / den, ci = (xi * are - xr * aim) / den;
        for (int n = 0; n < 16; ++n) { const float b_r = P.in[I_S5BRE][(size_t)ix * 16 + n], b_i = P.in[I_S5BIM][(size_t)ix * 16 + n];
            BB[((dir * 64 + p) * 16 + n) * 2] = cr * b_r - ci * b_i; BB[((dir * 64 + p) * 16 + n) * 2 + 1] = cr * b_i + ci * b_r; }
        for (int n = 0; n < 16; ++n) { const size_t cx = ((size_t)(dir * 64 + g) * 16 + n) * 64 + p; CC[((dir * 16 + n) * 64 + p) * 2] = P.in[I_S5CRE][cx]; CC[((dir * 16 + n) * 64 + p) * 2 + 1] = P.in[I_S5CIM][cx]; }
        float* L8 = (float*)(F.ws + WS_S5L8) + ((size_t)(g * 2 + dir) * 64 + p) * 2; L8[0] = LP[((dir * 9 + 8) * 64 + p) * 2]; L8[1] = LP[((dir * 9 + 8) * 64 + p) * 2 + 1]; }
    __syncthreads();
    for (int i = F.tid; i < 2 * 8 * 256; i += 512) { const int dir = i >> 11, tau = (i >> 8) & 7, n = (i >> 4) & 15, m = i & 15; float s = 0.f;
        for (int p = 0; p < 64; ++p) { const float c_r = CC[((dir * 16 + n) * 64 + p) * 2], c_i = CC[((dir * 16 + n) * 64 + p) * 2 + 1], l_r = LP[((dir * 9 + tau) * 64 + p) * 2], l_i = LP[((dir * 9 + tau) * 64 + p) * 2 + 1];
            const float w_r = c_r * l_r - c_i * l_i, w_i = c_r * l_i + c_i * l_r; const float b_r = BB[((dir * 64 + p) * 16 + m) * 2], b_i = BB[((dir * 64 + p) * 16 + m) * 2 + 1];
            s += w_r * b_r - w_i * b_i; }
        KT[i] = s; }
    __syncthreads();
    bf16_t* FBg = (bf16_t*)(F.ws + WS_S5FB) + (size_t)g * 2 * 32 * 512; bf16_t* EBg = (bf16_t*)(F.ws + WS_S5EB) + (size_t)g * 2 * 32 * 512; bf16_t* MBg = (bf16_t*)(F.ws + WS_S5MB) + (size_t)g * 32 * 512;
    const float* Dv = P.in[I_S5D] + g * 16;
    for (int i = F.tid; i < 2 * 32 * 512; i += 512) { const int j = i & 7, lane = (i >> 3) & 63, frag = (i >> 9) & 31, dir = i >> 14; const int h = lane >> 5, col = lane & 31;
        {
            const int s = frag >> 2, jn = frag & 3, p = (jn >> 1) * 32 + col, c = jn & 1, m = 8 * h + j, pw = dir == 0 ? 7 - s : s;
            const float l_r = LP[((dir * 9 + pw) * 64 + p) * 2], l_i = LP[((dir * 9 + pw) * 64 + p) * 2 + 1], b_r = BB[((dir * 64 + p) * 16 + m) * 2], b_i = BB[((dir * 64 + p) * 16 + m) * 2 + 1];
            FBg[i] = (bf16_t)f2bf(c == 0 ? l_r * b_r - l_i * b_i : l_r * b_i + l_i * b_r); }
        {
            const int ks = frag >> 2, jn = frag & 3, t = 2 * jn + (col >> 4), n = col & 15, k = 16 * ks + 8 * h + j, p = k >> 1, c = k & 1, pw = dir == 0 ? t + 1 : 8 - t;
            const float c_r = CC[((dir * 16 + n) * 64 + p) * 2], c_i = CC[((dir * 16 + n) * 64 + p) * 2 + 1], l_r = LP[((dir * 9 + pw) * 64 + p) * 2], l_i = LP[((dir * 9 + pw) * 64 + p) * 2 + 1];
            EBg[i] = (bf16_t)f2bf(c == 0 ? c_r * l_r - c_i * l_i : -(c_r * l_i + c_i * l_r)); } }
    for (int i = F.tid; i < 32 * 512; i += 512) { const int j = i & 7, lane = (i >> 3) & 63, frag = i >> 9; const int h = lane >> 5, col = lane & 31;
        const int s = frag >> 2, jn = frag & 3, t = 2 * jn + (col >> 4), n = col & 15, m = 8 * h + j; float v = 0.f;
        if (t >= s) v += KT[((0 * 8 + (t - s)) * 16 + n) * 16 + m];
        if (s >= t) v += KT[((1 * 8 + (s - t)) * 16 + n) * 16 + m];
        if (t == s && n == m) v += Dv[n];
        MBg[i] = (bf16_t)f2bf(v); }
    __syncthreads();
}
constexpr int BG_GLU = 512, BG_PER_E = 2112, BG_K0_END = BG_GLU + 8 * BG_PER_E, BG_TOTAL = BG_GLU + 16 * BG_PER_E;
constexpr int BG_R12_LO = BG_GLU, BG_R12_HI = BG_GLU + 2000;
constexpr int BG_R16_LO = BG_K0_END, BG_R16_HI = BG_K0_END + 6000;
constexpr int BG_S5A_LO = BG_R16_HI, BG_S5A_HI = BG_R16_HI + 7000;
__device__ __forceinline__ void bg_items(const Params& P, unsigned char* ws, int lo, int hi, int sw, int NSW, int lane, LAS unsigned char* tile) {
    TLoad La, Lb;
#define BG_JOB(g_, J_, it_) do { int j_, r_; if ((g_) < BG_GLU) { j_ = 46; r_ = (g_); } else { const int q_ = (g_) - BG_GLU, ke_ = q_ / BG_PER_E, rr_ = q_ % BG_PER_E; if (rr_ < 1408) { j_ = 14 + 2 * ke_; r_ = rr_; } else { j_ = 15 + 2 * ke_; r_ = rr_ - 1408; } } \
        J_ = get_tjob(j_, P, ws); it_ = r_; } while (0)
    int g = lo + sw; TJob Ja, Jb; int ia = 0, ib = 0;
    if (g < hi) { BG_JOB(g, Ja, ia); tfast_load(Ja, ia, lane, La); }
    for (; g < hi; g += 2 * NSW) {
        const int g1 = g + NSW, g2 = g + 2 * NSW;
        if (g1 < hi) { BG_JOB(g1, Jb, ib); tfast_load(Jb, ib, lane, Lb); }
        tfast_store(Ja, ia, lane, La, tile);
        if (g1 < hi) { const TJob Jc = Jb; const int ic = ib; if (g2 < hi) { BG_JOB(g2, Ja, ia); tfast_load(Ja, ia, lane, La); } tfast_store(Jc, ic, lane, Lb, tile); }
    }
#undef BG_JOB
}
__device__ __forceinline__ void bg_convert(const Frame& F0, const Params& P, int lo, int hi, int c, int short_c0) {
    if (c < short_c0 || lo >= hi) return;
    const Frame F = refresh(F0);
    __syncthreads();
    bg_items(P, F.ws, lo, hi, (c - short_c0) * 8 + F.wave, (F.G - short_c0) * 8, F.lane, F.lds + F.wave * 12288);
    __syncthreads();
}
__device__ __forceinline__ void phase_p0(const Frame& F0, const Params& P) {
    const Frame F = refresh(F0);
    const bool bg = (F.G == 256);
    for (int g = F.blk; g < 64; g += F.G) s5_precompute(F, P, g);
    { f32x2* RT = (f32x2*)(F.ws + WS_ROPE);
      for (int i = F.blk * 512 + F.tid; i < SEQ * 16; i += F.G * 512) { const int t = i >> 4, a = (i >> 3) & 1, f = i & 7; const float pos = (float)(a == 0 ? (t >> 6) : (t & 63));
          const float inv = 1.0f / powf(10000.0f, (float)f / 8.0f); const float ang = pos * inv; RT[i] = (f32x2){cosf(ang), sinf(ang)}; } }
    float* MOD = (float*)(F.ws + CTL_MOD);
    int base = 0;
    { LAS float* ST = (LAS float*)(F.lds + 98304);
      for (int i = F.tid; i < 9 * 1024; i += 512) { const float cv = i < 8192 ? P.in[I_C][i] : P.in[I_CCTX][i - 8192]; ST[i] = siluf_(cv); }
      __syncthreads();
      if ((F.gw & 1) == 0) { for (int it = F.gw >> 1; it < 4 * 192; it += (F.NGW + 1) >> 1) adaln_task(P, MOD, ST, it, F.lane); } }
    LAS float* scr = (LAS float*)(F.lds + F.wave * 12288);
    LAS unsigned char* tile = F.lds + F.wave * 12288;
    for (int j = 0; j < N_TJOBS; ++j) { if (bg && j >= 14 && j <= 46) continue;
        const TJob J = get_tjob(j, P, F.ws);
        const bool fast = (J.map == 0 || J.map == 1) && (J.NR % 64 == 0);
        const int n = fast ? (J.K / 64) * (J.NR / 64) : (J.K / 64) * (J.NR / 32);
        int first = (F.gw - base) % F.NGW; if (first < 0) first += F.NGW;
        if (fast) { TLoad La, Lb;
            if (first < n) tfast_load(J, first, F.lane, La);
            for (int it = first; it < n; it += 2 * F.NGW) {
                if (it + F.NGW < n) tfast_load(J, it + F.NGW, F.lane, Lb);
                tfast_store(J, it, F.lane, La, tile);
                if (it + F.NGW < n) { if (it + 2 * F.NGW < n) tfast_load(J, it + 2 * F.NGW, F.lane, La); tfast_store(J, it + F.NGW, F.lane, Lb, tile); } } }
        else for (int it = first; it < n; it += F.NGW) transpose_item(J, scr, it, F.lane);
        base += n; }
    if (bg) { bg_convert(F, P, 0, BG_R12_LO, F.blk, 0); bg_convert(F, P, BG_R12_HI, BG_R16_LO, F.blk, 0); bg_convert(F, P, BG_S5A_HI, BG_TOTAL, F.blk, 64); }
}

__device__ __forceinline__ void s5_chunk_rows(int dir, int b, int Ppos, int& row0) {
    int cn; bool ctx;
    if (dir == 0) { ctx = Ppos < 32; cn = ctx ? Ppos : Ppos - 32; } else { ctx = Ppos < 32; cn = ctx ? 31 - Ppos : 543 - Ppos; }
    row0 = ctx ? NLAT + b * CTX + cn * 8 : b * SEQ + cn * 8;
}
__device__ __forceinline__ void s5_mfma_stage(f32x16 (&acc)[4], const bf16x8 (&a)[8], const LAS unsigned char* fb, int lane) {
    bf16x8 f[2][4];
#pragma unroll
    for (int jn = 0; jn < 4; ++jn) f[0][jn] = *(const LAS bf16x8*)(fb + (jn * 64 + lane) * 16);
#pragma unroll
    for (int s = 0; s < 8; ++s) {
        if (s < 7) {
#pragma unroll
            for (int jn = 0; jn < 4; ++jn) f[(s + 1) & 1][jn] = *(const LAS bf16x8*)(fb + (((s + 1) * 4 + jn) * 64 + lane) * 16); }
#pragma unroll
        for (int jn = 0; jn < 4; ++jn) acc[jn] = __builtin_amdgcn_mfma_f32_32x32x16_bf16(a[s], f[s & 1][jn], acc[jn], 0, 0, 0);
        asm volatile("" ::: "memory");
    }
}
__device__ __forceinline__ void phase_s5a(const Frame& F0, const Params& P, bool bg) {
    const Frame F = refresh(F0);
    const bf16_t* Hg = (const bf16_t*)(F.ws + WS_H); bf16_t* SIN = (bf16_t*)(F.ws + WS_BIG + B_SIN);
    for (int item = F.blk; item < 256; item += F.G) {
        const int gd = item >> 1, g = gd >> 1, dir = gd & 1;
        __syncthreads();
        { const u32x4* src = (const u32x4*)((const bf16_t*)(F.ws + WS_S5FB) + (size_t)gd * 32 * 512); LAS u32x4* dst = (LAS u32x4*)F.lds;
          for (int i = F.tid; i < 2048; i += 512) dst[i] = src[i]; }
        __syncthreads();
        if (F.wave < 2) {
            const int pair = (item & 1) * 2 + F.wave; const int lane = F.lane, rho = lane & 31, h = lane >> 5, ncol = rho, hi = h;
            const int bA = pair * 2 + ((rho >> 2) & 1), rA = (rho & 3) + 4 * (rho >> 3);
            const int bS = pair * 2 + hi;
            const float* L8 = (const float*)(F.ws + WS_S5L8) + (size_t)gd * 128;
            const float a0r = L8[ncol * 2], a0i = L8[ncol * 2 + 1], a1r = L8[(32 + ncol) * 2], a1i = L8[(32 + ncol) * 2 + 1];
            float s0r = 0.f, s0i = 0.f, s1r = 0.f, s1i = 0.f;
            bf16_t* sinb = SIN + ((size_t)(g * 2 + dir) * 8 + bS) * 544 * 128;
            { unsigned* z = (unsigned*)sinb; z[ncol] = 0u; z[32 + ncol] = 0u; }
            const bf16_t* hgb = Hg + (size_t)g * MT * 16 + 8 * h;
            bf16x8 ua[8], un[8];
            { int row0; s5_chunk_rows(dir, bA, rA, row0);
#pragma unroll
              for (int s = 0; s < 8; ++s) ua[s] = *(const GAS bf16x8*)(hgb + (size_t)(row0 + s) * 16); }
            for (int tile = 0; tile < 34; ++tile) {
                { int row0; s5_chunk_rows(dir, bA, (tile < 33 ? tile + 1 : tile) * 16 + rA, row0);
#pragma unroll
                  for (int s = 0; s < 8; ++s) un[s] = *(const GAS bf16x8*)(hgb + (size_t)(row0 + s) * 16); }
                f32x16 acc[4];
#pragma unroll
                for (int jn = 0; jn < 4; ++jn) acc[jn] = f32x16{};
                s5_mfma_stage(acc, ua, F.lds, lane);
                unsigned* dbase = (unsigned*)(sinb + (size_t)(tile * 16 + 1) * 128) + ncol;
#pragma unroll
                for (int r = 0; r < 16; ++r) {
                    float nr = a0r * s0r - a0i * s0i + acc[0][r], ni = a0r * s0i + a0i * s0r + acc[1][r]; s0r = nr; s0i = ni;
                    nr = a1r * s1r - a1i * s1i + acc[2][r]; ni = a1r * s1i + a1i * s1r + acc[3][r]; s1r = nr; s1i = ni;
                    if (r < 15 || tile < 33) { dbase[r * 64] = pk2(s0r, s0i); dbase[r * 64 + 32] = pk2(s1r, s1i); } }
#pragma unroll
                for (int s = 0; s < 8; ++s) ua[s] = un[s];
            }
        }
        else if (bg && item == F.blk) bg_items(P, F.ws, BG_S5A_LO, BG_S5A_HI, F.blk * 6 + (F.wave - 2), F.G * 6, F.lane, F.lds + 32768 + (F.wave - 2) * 12288);
    }
    __syncthreads();
}
__device__ __forceinline__ void phase_s5b(const Frame& F0) {
    const Frame F = refresh(F0);
    const bf16_t* Hg = (const bf16_t*)(F.ws + WS_H); const bf16_t* SIN = (const bf16_t*)(F.ws + WS_BIG + B_SIN); bf16_t* Gout = (bf16_t*)(F.ws + WS_BIG + B_G);
    for (int item = F.blk; item < 256; item += F.G) {
        const int g = item >> 2, qt = item & 3;
        __syncthreads();
        { const u32x4* s1 = (const u32x4*)((const bf16_t*)(F.ws + WS_S5MB) + (size_t)g * 32 * 512); const u32x4* s2 = (const u32x4*)((const bf16_t*)(F.ws + WS_S5EB) + (size_t)g * 64 * 512); LAS u32x4* dst = (LAS u32x4*)F.lds;
          for (int i = F.tid; i < 2048; i += 512) dst[i] = s1[i];
          for (int i = F.tid; i < 4096; i += 512) dst[2048 + i] = s2[i]; }
        __syncthreads();
        const int lane = F.lane, rho = lane & 31, h = lane >> 5;
        for (int tile = qt * 34 + F.wave; tile < qt * 34 + 34; tile += 8) {
            const int b = tile / 17, tq = tile % 17;
            const int rowbase = tq == 0 ? NLAT + b * CTX : b * SEQ + (tq - 1) * 256;
            const int cc = tq * 32 + rho; const int Pf = cc, Pr = tq == 0 ? 31 - cc : 575 - cc;
            const bf16_t* up = Hg + ((size_t)g * MT + rowbase + rho * 8) * 16 + 8 * h;
            const bf16_t* sf = SIN + (((size_t)(g * 2 + 0) * 8 + b) * 544 + Pf) * 128 + 8 * h; const bf16_t* sr = SIN + (((size_t)(g * 2 + 1) * 8 + b) * 544 + Pr) * 128 + 8 * h;
            f32x16 acc[4];
#pragma unroll
            for (int jn = 0; jn < 4; ++jn) acc[jn] = f32x16{};
            bf16x8 a[8], af[8], ar[8];
#pragma unroll
            for (int s = 0; s < 8; ++s) { a[s] = *(const GAS bf16x8*)(up + 16 * s); af[s] = *(const GAS bf16x8*)(sf + 16 * s); ar[s] = *(const GAS bf16x8*)(sr + 16 * s); }
            s5_mfma_stage(acc, a, F.lds, lane);
            s5_mfma_stage(acc, af, F.lds + 32768, lane);
            s5_mfma_stage(acc, ar, F.lds + 65536, lane);
            const int col = lane & 31, n = col & 15, toff = col >> 4;
            bf16_t* ob = Gout + (size_t)(rowbase + 32 * h + toff) * DM + g * 16 + n;
#pragma unroll
            for (int r = 0; r < 16; ++r)
#pragma unroll
                for (int jn = 0; jn < 4; ++jn) ob[(size_t)(8 * ((r & 3) + 8 * (r >> 2)) + 2 * jn) * DM] = (bf16_t)f2bf(gelu_tanh(acc[jn][r]));
        }
    }
    __syncthreads();
}

constexpr int LDS_BYTES = 163840;
constexpr int LDSCTL_OFF = 159744;
constexpr int N_PHASES = 33;

__device__ __forceinline__ unsigned char* wmla(unsigned char* ws, int j) { return ws + WS_W + WO_MLA + (size_t)j * W_MLA_SZ; }

__device__ __forceinline__ void moe_fixup(const Frame& F0, const pg8::Sched& S, bf16_t* Y, const float* SLAB) {
    const Frame F = refresh(F0);
    const int R = S.nwg / S.G, T = S.nwg - R * S.G;
    for (int task = F.gw; task < T * 256; task += F.NGW) { const int tu = task >> 8, r = task & 255; pg8::Unit u; S.map((long)R * S.G + tu, u);
        f32x4 a = *(const GAS f32x4*)(SLAB + ((size_t)tu * 256 + r) * 256 + 4 * F.lane);
        for (int s = 1; s < S.S; ++s) a = a + *(const GAS f32x4*)(SLAB + ((size_t)(s * T + tu) * 256 + r) * 256 + 4 * F.lane);
        u32x2 w; w.x = pk2(a[0], a[1]); w.y = pk2(a[2], a[3]); *(GAS u32x2*)(Y + ((size_t)u.pm * 256 + r) * DM + u.pn * 256 + 4 * F.lane) = w; }
}

__global__ void __launch_bounds__(512, 2) fwd_kernel(Params P) {
    extern __shared__ __attribute__((aligned(16))) unsigned char lds_raw[];
    Frame F; F.lds = (LAS unsigned char*)lds_raw; F.tid = threadIdx.x; F.lane = F.tid & 63; F.wave = __builtin_amdgcn_readfirstlane(F.tid >> 6);
    F.blk = blockIdx.x; F.G = gridDim.x; F.gw = F.blk * 8 + F.wave; F.NGW = F.G * 8; F.ws = P.ws;
    unsigned char* ws = P.ws;
    const int lo = P.ph_lo, hi = P.ph_hi;
    { int t0 = threadIdx.x; asm volatile("" : "+v"(t0)); for (int u = t0; u < (LDS_BYTES - LDSCTL_OFF) / 4; u += 512) ((LAS unsigned*)(F.lds + LDSCTL_OFF))[u] = 0u; }
    __syncthreads();
    unsigned* barw = (unsigned*)(ws + CTL_BAR) + (size_t)P.li * XCD_BAR_WORDS;
    XcdBarrier bar; bar.bar = barw; bar.x = 0; bar.st = (volatile LAS unsigned*)(F.lds + LDSCTL_OFF + 64);
    if (hi - lo > 1) bar = xcd_barrier_post(barw, (volatile LAS unsigned*)(F.lds + LDSCTL_OFF + 64));
#ifndef ONLY_LO
#define ONLY_LO 0
#define ONLY_HI 99
#endif
#define IN(k) ((k) >= ONLY_LO && (k) < ONLY_HI && lo <= (k) && (k) < hi)
#define SEAM(k) do { if (IN((k) + 1)) xcd_barrier(bar); } while (0)
    float* MOD = (float*)(ws + CTL_MOD); bf16_t* X = (bf16_t*)(ws + WS_X); bf16_t* H = (bf16_t*)(ws + WS_H); unsigned char* BIG = ws + WS_BIG;
    float* SSQ = (float*)(ws + WS_SSQ); const f32x2* ROPE_T = (const f32x2*)(ws + WS_ROPE);
    const int* TILEE = (const int*)(ws + WS_TILEE);
    const int vcu = (F.G % 8 == 0) ? (F.blk % 8) * (F.G / 8) + F.blk / 8 : F.blk;
    const int c2 = (F.G % 8 == 0 && F.G >= 256) ? (F.blk + F.G / 2) % F.G : F.blk;

#ifndef T_NOKR
#define T_NOKR 0
#endif
#ifndef T_NOUQ
#define T_NOUQ 0
#endif
#ifndef T_NOKV
#define T_NOKV 0
#endif
    const bool BGMODE = (F.G == 256) && !P.pad;
    bf16_t* Xr = P.pad ? (bf16_t*)(BIG + (size_t)360 * MiB) : X;
#define MODP(l, k) (MOD + (size_t)(l) * 9 * 6144 + (k) * 1024)
#define GEMMX(EPI, e, Aptr, lda_, Bptr, K_, nM_, nN_, cc, SPLIT) do { pg8::Sched S; S.init((nM_), (nN_), F.G, (cc), (K_) / 64, (SPLIT)); S.A = (const char*)(Aptr); S.a_tile = (size_t)256 * (lda_) * 2; S.B = (const char*)(Bptr); S.b_tile = (size_t)256 * (K_) * 2; \
        pg8::gemm_phase<EPI>(F.lds, (K_), (lda_), S, e); } while (0)
#define GEMM(EPI, e, Aptr, lda_, Bptr, K_, nM_, nN_, cc) GEMMX(EPI, e, Aptr, lda_, Bptr, K_, nM_, nN_, cc, false)

    if (IN(0)) { phase_p0(F, P); SEAM(0); }

#define MLA_LAYER(PH, L, J, QROWS_TILES, CTXQ) \
    if (IN(PH)) { EpiZ e{(bf16_t*)(BIG + B_Z), SSQ}; GEMM(EpiZ, e, H, DM, wmla(ws, J) + W_DQKV, DM, MT / 256, 3, F.blk); SEAM(PH); } \
    if (IN(PH + 1)) { if (!T_NOKR) phase_krope(F, MT); \
        if (!T_NOUQ) { EpiQ e{(bf16_t*)(BIG + B_Q), SSQ, ROPE_T}; GEMM(EpiQ, e, BIG + B_Z, ZW, wmla(ws, J) + W_UQ, QLORA, QROWS_TILES, 6, F.blk); } \
        if (!T_NOKV) { EpiKV e{(bf16_t*)(BIG + B_K), (bf16_t*)(BIG + B_V), SSQ}; GEMM(EpiKV, e, BIG + B_Z + QLORA * 2, ZW, wmla(ws, J) + W_UKV, KVLORA, MT / 256, 8, c2); } \
        SEAM(PH + 1); } \
    if (IN(PH + 2)) { const bf16_t* Qb = (const bf16_t*)(BIG + B_Q); const bf16_t* Kb = (const bf16_t*)(BIG + B_K); const bf16_t* Vb = (const bf16_t*)(BIG + B_V); const bf16_t* KRb = (const bf16_t*)(BIG + B_KR); \
        for (int ui = vcu; ui < NB * NHEAD * 16; ui += F.G) { const int bh = ui >> 4, qb = ui & 15, b = bh >> 4, h = bh & 15; \
            att::attn_unit(Qb, Kb, Vb, H, KRb, b * SEQ + qb * 256, NLAT + b * CTX, b * SEQ, h, 68, F.lds); } \
        if (CTXQ) for (int ui = vcu; ui < NB * NHEAD; ui += F.G) { const int b = ui >> 4, h = ui & 15; att::attn_unit(Qb, Kb, Vb, H, KRb, NLAT + b * CTX, NLAT + b * CTX, b * SEQ, h, 4, F.lds); } \
        SEAM(PH + 2); } \
    if (IN(PH + 3)) { EpiResid e{Xr, MODP(L, 2), nullptr, (float*)(BIG + B_SLAB)}; GEMMX(EpiResid, e, H, DM, wmla(ws, J) + W_O, DM, QROWS_TILES, 4, F.blk, (L) == 0 && !P.pad); SEAM(PH + 3); }

#define FFN_LAYER(PH, L, KF) \
    if (IN(PH)) { EpiSwiGLU e{(bf16_t*)BIG}; GEMM(EpiSwiGLU, e, H, DM, ws + WS_W + WO_FFN + (size_t)(KF) * W_FFN_SZ, DM, MT / 256, 22, F.blk); SEAM(PH); } \
    if (IN(PH + 1)) { EpiResid e{Xr, MODP(L, 5), nullptr, (float*)(BIG + B_SLAB)}; GEMMX(EpiResid, e, BIG, FFN, ws + WS_W + WO_FFN + (size_t)(KF) * W_FFN_SZ + W_GU_SZ, FFN, MT / 256, 4, F.blk, !P.pad); SEAM(PH + 1); }

#define MOE_LAYER(PH, KM, NROWS) \
    if (IN(PH)) { phase_scatter(F, NROWS); SEAM(PH); } \
    if (IN(PH + 1)) { const int ntm = __builtin_amdgcn_readfirstlane(TILEE[511]); pg8::Sched S; S.init(ntm, 22, F.G, F.blk, DM / 64); S.A = (const char*)H; S.a_tile = 0; S.gather = (const int*)(ws + WS_S2R); \
        S.B = (const char*)(ws + WS_W + WO_MOE + (size_t)(KM) * 8 * W_FFN_SZ); S.b_tile = (size_t)256 * DM * 2; S.b_exp = W_FFN_SZ; S.tile_e = TILEE; \
        EpiSwiGLU e{(bf16_t*)(BIG + B_ACTM)}; pg8::gemm_phase<EpiSwiGLU, true, true>(F.lds, DM, DM, S, e); SEAM(PH + 1); } \
    if (IN(PH + 2)) { const int ntm = __builtin_amdgcn_readfirstlane(TILEE[511]); pg8::Sched S; const bool msplit = (KM) == 1 && !P.pad && (hi - lo > 1);     \
        S.init(ntm, 4, F.G, F.blk, FFN / 64, msplit, 8); S.A = (const char*)(BIG + B_ACTM); S.a_tile = (size_t)256 * FFN * 2; \
        S.B = (const char*)(ws + WS_W + WO_MOE + (size_t)(KM) * 8 * W_FFN_SZ + W_GU_SZ); S.b_tile = (size_t)256 * FFN * 2; S.b_exp = W_FFN_SZ; S.tile_e = TILEE; \
        EpiBf16 e{(bf16_t*)(BIG + B_XG), DM, (float*)(ws + WS_SLAB2)}; pg8::gemm_phase<EpiBf16>(F.lds, FFN, FFN, S, e); \
        if (BGMODE && (KM) == 0) { int sc0 = (ntm * 4) % 256; if (256 - sc0 < 128) sc0 = 0; bg_convert(F, P, BG_R16_LO, BG_R16_HI, F.blk, sc0); } \
        if (S.S > 1) { xcd_barrier(bar); moe_fixup(F, S, (bf16_t*)(BIG + B_XG), (const float*)(ws + WS_SLAB2)); }     \
        SEAM(PH + 2); }

    if (IN(1)) { phase_rows<1, false, 0, false>(F, P, MT, P.in[I_N1G] + 0 * DM, MODP(0, 0), nullptr, 0, nullptr, nullptr, 0); SEAM(1); }
    MLA_LAYER(2, 0, 0, MT / 256, true)
    if (IN(6)) { phase_rows<0, false, 0, false, true>(F, P, MT, P.in[I_N2G] + 0 * DM, MODP(0, 3), nullptr, 0, nullptr, nullptr, 0, DM / 64); SEAM(6); }
    FFN_LAYER(7, 0, 0)
    if (IN(9)) { phase_rows<0, false, 1, false, true>(F, P, MT, P.in[I_N1G] + 1 * DM, MODP(1, 0), nullptr, 0, nullptr, nullptr, 0, FFN / 64); SEAM(9); }
    if (IN(10)) { phase_s5a(F, P, BGMODE); SEAM(10); }
    if (IN(11)) { phase_s5b(F); SEAM(11); }
    if (IN(12)) { EpiGLU e{X, MODP(1, 2)}; GEMM(EpiGLU, e, BIG + B_G, DM, ws + WS_W + WO_GLU, DM, MT / 256, 8, F.blk); if (BGMODE) bg_convert(F, P, BG_R12_LO, BG_R12_HI, F.blk, 64); SEAM(12); }
    if (IN(13)) { phase_rows<0, false, 0, true>(F, P, MT, P.in[I_N2G] + 1 * DM, MODP(1, 3), nullptr, 0, P.in[I_MRW], P.in[I_MRB], MT); SEAM(13); }
    MOE_LAYER(14, 0, MT)
    if (IN(17)) { phase_rows<0, true, 0, false>(F, P, MT, P.in[I_N1G] + 2 * DM, MODP(2, 0), MODP(1, 5), MT, nullptr, nullptr, 0); SEAM(17); }
    if (IN(18)) { phase_pool(F); SEAM(18); }
    if (IN(19)) { pg8::Sched S; S.init(MT / 256, 4, F.G, F.blk, 256 / 64); S.A = (const char*)BIG; S.a_tile = (size_t)256 * DM * 2; S.a_pn = 512; S.B = (const char*)(ws + WS_W + WO_POOL); S.b_tile = (size_t)256 * 256 * 2;
        EpiResidT<true> e{X, MODP(2, 2), P.in[I_POOLS], nullptr}; pg8::gemm_phase<EpiResidT<true>>(F.lds, 256, DM, S, e); SEAM(19); }
    if (IN(20)) { phase_rows<0, false, 0, false>(F, P, MT, P.in[I_N2G] + 2 * DM, MODP(2, 3), nullptr, 0, nullptr, nullptr, 0); SEAM(20); }
    FFN_LAYER(21, 2, 1)
    if (IN(23)) { phase_rows<0, false, 0, false, true>(F, P, MT, P.in[I_N1G] + 3 * DM, MODP(3, 0), nullptr, 0, nullptr, nullptr, 0, FFN / 64); SEAM(23); }
    MLA_LAYER(24, 3, 1, NLAT / 256, false)
    if (IN(28)) { phase_rows<0, false, 0, true>(F, P, NLAT, P.in[I_N2G] + 3 * DM, MODP(3, 3), nullptr, 0, P.in[I_MRW] + DM * NEXP, P.in[I_MRB] + NEXP, NLAT); SEAM(28); }
    MOE_LAYER(29, 1, NLAT)
    if (IN(32)) { phase_rows<0, true, 2, false>(F, P, NLAT, P.in[I_FNG], nullptr, MODP(3, 5), NLAT, nullptr, nullptr, 0); }
#undef IN
#undef SEAM
}

#ifndef MK_PER_PHASE
#define MK_PER_PHASE 0
#endif
extern "C" void kernel_launch(void* const* d_in, const int* in_sizes, int n_in, void* d_out, int out_size, void* d_ws, size_t ws_size, hipStream_t stream) {
    static int grid = 0;
    if (grid == 0) {
        if (n_in != 33 || ws_size < WS_END) { fprintf(stderr, "kernel_launch: n_in %d ws %zu (need %zu)\n", n_in, ws_size, (size_t)WS_END); grid = -1; return; }
        int dev = 0, cus = 0;
        if (hipGetDevice(&dev) != hipSuccess || hipDeviceGetAttribute(&cus, hipDeviceAttributeMultiprocessorCount, dev) != hipSuccess) { grid = -1; return; }
        if (hipFuncSetAttribute((const void*)fwd_kernel, hipFuncAttributeMaxDynamicSharedMemorySize, LDS_BYTES) != hipSuccess) { grid = -1; return; }
        int per_cu = 0; (void)hipOccupancyMaxActiveBlocksPerMultiprocessor(&per_cu, (const void*)fwd_kernel, 512, LDS_BYTES); (void)hipGetLastError();
        grid = cus > 256 ? 256 : cus;
    }
    if (grid < 0) return;
    (void)hipMemsetAsync((char*)d_ws + WS_CTL, 0, CTL_ZERO_BYTES, stream);
    Params p{};
    for (int i = 0; i < 33; ++i) p.in[i] = (const float*)d_in[i];
    p.out = (float*)d_out; p.ws = (unsigned char*)d_ws;
#if MK_PER_PHASE
    for (int k = 0; k < N_PHASES; ++k) { p.ph_lo = k; p.ph_hi = k + 1; hipLaunchKernelGGL(fwd_kernel, dim3(grid), dim3(512), LDS_BYTES, stream, p); }
#elif defined(PROBE_REPEAT)
    {
      const int rep[] = {PROBE_REPEAT}; const int nrep = sizeof(rep) / sizeof(rep[0]); int prev = 0;
      for (int i = 0; i < nrep; ++i) { p.li = i; p.ph_lo = prev; p.ph_hi = rep[i] + 1; hipLaunchKernelGGL(fwd_kernel, dim3(grid), dim3(512), LDS_BYTES, stream, p);
          p.ph_lo = rep[i]; p.ph_hi = rep[i] + 1; p.pad = 1; hipLaunchKernelGGL(fwd_kernel, dim3(grid), dim3(512), LDS_BYTES, stream, p); p.pad = 0; prev = rep[i] + 1; }
      if (prev < N_PHASES) { p.li = nrep; p.ph_lo = prev; p.ph_hi = N_PHASES; hipLaunchKernelGGL(fwd_kernel, dim3(grid), dim3(512), LDS_BYTES, stream, p); } }
#else
    p.ph_lo = 0; p.ph_hi = N_PHASES; hipLaunchKernelGGL(fwd_kernel, dim3(grid), dim3(512), LDS_BYTES, stream, p);
#endif
}
```

```cpp
#include <hip/hip_runtime.h>
#include <hip/hip_bf16.h>
#include <cstdio>
#include <cstdint>

#define LAS __attribute__((address_space(3)))
#define GAS __attribute__((address_space(1)))
typedef unsigned short bf16_t;
typedef short bf16x8 __attribute__((ext_vector_type(8)));
typedef short s16x4 __attribute__((ext_vector_type(4)));
typedef float f32x4 __attribute__((ext_vector_type(4)));
typedef float f32x2 __attribute__((ext_vector_type(2)));
typedef float f32x16 __attribute__((ext_vector_type(16)));
typedef unsigned u32x4 __attribute__((ext_vector_type(4)));
typedef unsigned u32x2 __attribute__((ext_vector_type(2)));

constexpr int DM = 1024, NB = 8, SEQ = 4096, CTX = 256;
constexpr int NLAT = NB * SEQ;
constexpr int NCTX = NB * CTX;
constexpr int MT = NLAT + NCTX;
constexpr int QLORA = 384, KVLORA = 256, ROPE = 32, NHEAD = 16, QKD = 96, VD = 64;
constexpr int ZW = 768;
constexpr int FFN = 2816, NEXP = 8;
constexpr float EPS = 1e-6f;
constexpr int NKEY = CTX + SEQ;
constexpr float ATT_C2 = 0.10206207261596577f * 1.4426950408889634f;

__device__ __forceinline__ unsigned f2bf(float f) { unsigned u = __builtin_bit_cast(unsigned, f); return (u + 0x7fffu + ((u >> 16) & 1u)) >> 16; }
__device__ __forceinline__ float bf2f(unsigned short b) { return __builtin_bit_cast(float, ((unsigned)b) << 16); }
__device__ __forceinline__ unsigned cvt_pk_bf16(float lo, float hi) { unsigned r; asm volatile("v_cvt_pk_bf16_f32 %0, %1, %2" : "=v"(r) : "v"(lo), "v"(hi)); return r; }
__device__ __forceinline__ unsigned pk2(float lo, float hi) { return cvt_pk_bf16(lo, hi); }
__device__ __forceinline__ float wave_sum(float v) {
#pragma unroll
    for (int o = 1; o < 64; o <<= 1) v += __shfl_xor(v, o);
    return v;
}
template <int CTRL, int ROWMASK> __device__ __forceinline__ float dpp_f(float v) { return __int_as_float(__builtin_amdgcn_update_dpp(0, __float_as_int(v), CTRL, ROWMASK, 0xF, true)); }
__device__ __forceinline__ float wave_sum_dpp(float v) {
    v += dpp_f<0xB1, 0xF>(v); v += dpp_f<0x4E, 0xF>(v); v += dpp_f<0x141, 0xF>(v); v += dpp_f<0x140, 0xF>(v);
    v += dpp_f<0x142, 0xA>(v); v += dpp_f<0x143, 0xC>(v);
    return __int_as_float(__builtin_amdgcn_readlane(__float_as_int(v), 63));
}
__device__ __forceinline__ float sigmoidf_(float x) { return __builtin_amdgcn_rcpf(1.0f + __builtin_amdgcn_exp2f(x * -1.4426950408889634f)); }
__device__ __forceinline__ float siluf_(float x) { return x * sigmoidf_(x); }
__device__ __forceinline__ float gelu_tanh(float x) { const float u = 1.5957691216057308f * (x + 0.044715f * x * x * x); return x * sigmoidf_(u); }

#define XB_TMO      128
#define XB_XCNT(j)  (256  + 64 * (j))
#define XB_XSUB(j)  (1280 + 64 * (j))
#define XB_XGEN(j)  (2304 + 64 * (j))
#define XB_TOP      3328
#define XB_TOPGEN   3392
#define XCD_BAR_WORDS 3456
#define XB_SPIN_CAP (1u << 18)
__device__ __forceinline__ unsigned xb_ld(unsigned* p)              { return __hip_atomic_load(p, __ATOMIC_RELAXED, __HIP_MEMORY_SCOPE_AGENT); }
__device__ __forceinline__ unsigned xb_add(unsigned* p, unsigned v) { return __hip_atomic_fetch_add(p, v, __ATOMIC_RELAXED, __HIP_MEMORY_SCOPE_AGENT); }
__device__ __forceinline__ unsigned xb_xcc_id() { return (unsigned)__builtin_amdgcn_s_getreg((3 << 11) | 20) & 0xFu; }
#define XB_SPIN(cond, bar) do { unsigned _sp = 0; while (cond) { __builtin_amdgcn_s_sleep(1); \
    if ((++_sp & 255u) == 0u) { if (xb_ld(&(bar)[XB_TMO])) break; if (_sp > XB_SPIN_CAP) { atomicAdd(&(bar)[XB_TMO], 1u); break; } } } } while (0)
struct XcdBarrier { unsigned* bar; unsigned x; volatile LAS unsigned* st; };
__device__ __forceinline__ XcdBarrier xcd_barrier_post(unsigned* bar, volatile LAS unsigned* st) {
    XcdBarrier b; b.bar = bar; b.x = xb_xcc_id(); b.st = st;
    if (threadIdx.x == 0) (void)xb_add(&bar[XB_XCNT(b.x)], 1u);
    return b;
}
__device__ __forceinline__ void xcd_barrier_complete(unsigned* bar, unsigned x, unsigned& nloc, unsigned& nx) {
    const unsigned G = gridDim.x * gridDim.y * gridDim.z;
    unsigned sum, cnt, mine, sp = 0u;
    for (;;) {
        sum = 0u; cnt = 0u; mine = 0u;
#pragma unroll
        for (unsigned j = 0; j < 16; ++j) { const unsigned c = xb_ld(&bar[XB_XCNT(j)]); sum += c; cnt += (c > 0u) ? 1u : 0u; mine = (j == x) ? c : mine; }
        if (sum == G) break;
        __builtin_amdgcn_s_sleep(1);
        if ((++sp & 255u) == 0u) { if (xb_ld(&bar[XB_TMO])) break; if (sp > XB_SPIN_CAP) { atomicAdd(&bar[XB_TMO], 1u); break; } }
    }
    nloc = mine > 0u ? mine : 1u; nx = cnt > 0u ? cnt : 1u;
}
__device__ __forceinline__ void xcd_barrier(const XcdBarrier& b) {
    asm volatile("s_waitcnt vmcnt(0)" ::: "memory");
    __syncthreads();
    if (threadIdx.x == 0) {
        unsigned* bar = b.bar;
        __builtin_amdgcn_s_waitcnt(0);
        unsigned nloc = b.st[0], nx = b.st[1];
        if (nloc == 0u) { xcd_barrier_complete(bar, b.x, nloc, nx); b.st[0] = nloc; b.st[1] = nx; }
        const unsigned old = xb_add(&bar[XB_XSUB(b.x)], 1u);
        const unsigned gen = old / nloc;
        if (old + 1u == (gen + 1u) * nloc) {
            __builtin_amdgcn_fence(__ATOMIC_RELEASE, "agent");
            asm volatile("s_waitcnt vmcnt(0)" ::: "memory");
            const unsigned og = xb_add(&bar[XB_TOP], 1u);
            const unsigned tg = og / nx;
            if (og + 1u == (tg + 1u) * nx) xb_add(&bar[XB_TOPGEN], 1u);
            else XB_SPIN(xb_ld(&bar[XB_TOPGEN]) == tg, bar);
            __builtin_amdgcn_fence(__ATOMIC_ACQUIRE, "agent");
            xb_add(&bar[XB_XGEN(b.x)], 1u);
            asm volatile("s_waitcnt vmcnt(0)" ::: "memory");
        } else {
            XB_SPIN(xb_ld(&bar[XB_XGEN(b.x)]) == gen, bar);
            __builtin_amdgcn_fence(__ATOMIC_ACQUIRE, "agent");
            asm volatile("s_waitcnt vmcnt(0)" ::: "memory");
        }
    }
    __syncthreads();
}

namespace pg8 {
constexpr int BM = 256, BK = 64, HALF = 128, HTB = HALF * BK * 2, STAGE_BYTES = 8 * HTB, NXCD = 8, WGM = 8;
__host__ __device__ __forceinline__ int lds_byte(int r, int c) { const int st = (r >> 4) * 2 + (c >> 5), rr = r & 15, cc = c & 31, ob = rr * 64 + cc * 2; return st * 1024 + (ob ^ (((ob >> 9) & 1) << 5)); }
__host__ __device__ __forceinline__ void stage_rc(int b, int& R, int& C) { const int st = b / 1024, sb = b % 1024, swz = sb ^ (((sb >> 9) & 1) << 5); R = (st >> 1) * 16 + swz / 64; C = (st & 1) * 32 + (swz % 64) / 2; }
__host__ __device__ __forceinline__ int perm32(int rho) { const int n = rho >> 4, i = rho & 15; return 8 * (i >> 2) + 4 * n + (i & 3); }
struct Unit { int pm, pn, k0, nt, slab; };

struct Sched {
    int nM, nN, nwg, G, c, ntot, S;
    const char* A; size_t a_tile, a_pn; const char* B; size_t b_tile, b_exp; const int* tile_e; const int* gather;
    __device__ __forceinline__ void init(int nM_, int nN_, int G_, int c_, int ntot_, bool split = false, int min_S = 2) {   nM = nM_; nN = nN_; nwg = nM * nN; G = G_; c = c_; ntot = ntot_; a_pn = 0; b_exp = 0; tile_e = nullptr; gather = nullptr;
        S = 1; if (split) { const int T = nwg % G; if (T > 0) { int s = G / T; if (s > 8) s = 8; if (s > ntot / 4) s = ntot / 4; if (s > 1 && s >= min_S) S = s; } } }
    __device__ __forceinline__ void map(long L, Unit& u) const {
        int wgid = (int)L; { const int q = nwg / NXCD, r = nwg % NXCD, xcd = wgid % NXCD, off = wgid / NXCD; wgid = (xcd < r ? xcd * (q + 1) : r * (q + 1) + (xcd - r) * q) + off; }
        const int nig = WGM * nN, gid = wgid / nig, fm = gid * WGM, gsz = (nM - fm) < WGM ? (nM - fm) : WGM;
        u.pm = fm + ((wgid % nig) % gsz); u.pn = (wgid % nig) / gsz; }
    __device__ __forceinline__ bool next(int i, Unit& u) const {
        if (S > 1) { const int R = nwg / G, T = nwg - R * G;
            if (i > R) return false;
            if (i == R) { if (c >= T * S) return false; const int tu = c % T, s = c / T; map((long)R * G + tu, u);
                const int base = (ntot / S) & ~1, rem2 = (ntot - base * S) >> 1; u.nt = base + (s < rem2 ? 2 : 0); u.k0 = s * base + 2 * (s < rem2 ? s : rem2); u.slab = s * T + tu; return true; } }
        const long L = (long)i * G + c; if (L >= nwg) return false;
        map(L, u); u.k0 = 0; u.nt = ntot; u.slab = -1; return true;
    }
    __device__ __forceinline__ const char* a_base(const Unit& u) const { return A + (size_t)u.pm * a_tile + (size_t)u.pn * a_pn + (size_t)u.k0 * 128; }
    __device__ __forceinline__ const char* b_base(const Unit& u) const { const int e = tile_e ? __builtin_amdgcn_readfirstlane(tile_e[u.pm]) : 0; return B + (size_t)e * b_exp + (size_t)u.pn * b_tile + (size_t)u.k0 * 128; }
};

constexpr int GATHER_LDS_OFF = 131072, GATHER_MAX_UNITS = 28;
template <class Epi, bool ALIGN_EPI = true, bool GATHER = false>
__device__ __forceinline__ void gemm_phase(LAS unsigned char* lds, const int K, const int lda, const Sched& S, const Epi& E) {
    int tid_ = threadIdx.x; asm volatile("" : "+v"(tid_));
    const int tid = tid_, wid = __builtin_amdgcn_readfirstlane(tid >> 6), lane = tid & 63, wr = wid >> 2, wc = wid & 3, fr = lane & 15, fq = lane >> 4;
    unsigned voffA[2][2], voffAn[2][2], voffB[2]; int aoff, boff;
#define PG8_LANECONST() do { int t_ = tid; asm volatile("" : "+v"(t_)); const int l_ = t_ & 63, fr_ = l_ & 15, fq_ = l_ >> 4; \
    _Pragma("unroll") for (int i = 0; i < 2; ++i) { int R, C; stage_rc(t_ * 16 + i * 8192, R, C); const int Rb = Epi::PERM ? ((R & ~31) + perm32(R & 31)) : R; \
        if (!GATHER) { voffA[0][i] = (unsigned)(R * lda + C) * 2u; voffA[1][i] = (unsigned)((R + HALF) * lda + C) * 2u; voffAn[0][i] = voffA[0][i]; voffAn[1][i] = voffA[1][i]; } voffB[i] = (unsigned)(Rb * K + C) * 2u; } \
    aoff = lds_byte(wr * 64 + fr_, fq_ * 8); boff = lds_byte(wc * 32 + fr_, fq_ * 8); } while (0)
    PG8_LANECONST();
#define PG8_GATHER_OFFS(dst, ui_) do { int t_ = tid; asm volatile("" : "+v"(t_)); _Pragma("unroll") for (int i = 0; i < 2; ++i) { int R, C; stage_rc(t_ * 16 + i * 8192, R, C); \
        const LAS int* gt_ = (const LAS int*)(lds + GATHER_LDS_OFF) + (ui_) * 256; dst[0][i] = (unsigned)(gt_[R] * lda + C) * 2u; dst[1][i] = (unsigned)(gt_[R + HALF] * lda + C) * 2u; } } while (0)
    if constexpr (GATHER) { Unit u_; for (int i = 0; i < GATHER_MAX_UNITS && S.next(i, u_); ++i) { if (tid < 256) ((LAS int*)(lds + GATHER_LDS_OFF))[i * 256 + tid] = S.gather[u_.pm * 256 + tid]; }
        asm volatile("s_waitcnt vmcnt(0) lgkmcnt(0)" ::: "memory"); __builtin_amdgcn_s_barrier(); PG8_GATHER_OFFS(voffA, 0); }
    const size_t kstep = (size_t)(BK * 2);
    const size_t hstepB = (size_t)HALF * K * 2;
    const unsigned ldsw = (unsigned)wid * 1024u;
#define PG8_SA(b, h) (((b) * 2 + (h)) * HTB)
#define PG8_SB(b, h) ((4 + (b) * 2 + (h)) * HTB)
#define PG8_STAGE(bufoff, gbase, voff) do { _Pragma("unroll") for (int _i = 0; _i < 2; ++_i) \
        __builtin_amdgcn_global_load_lds((const unsigned*)((const char*)(gbase) + (voff)[_i]), (LAS unsigned*)(lds + (bufoff) + ldsw + _i * 8192), 16, 0, 0); } while (0)
#define PG8_LDA(dst, b, h) do { _Pragma("unroll") for (int m = 0; m < 4; ++m) _Pragma("unroll") for (int k = 0; k < 2; ++k) dst[m][k] = *(const LAS bf16x8*)(lds + PG8_SA(b, h) + aoff + m * 2048 + k * 1024); } while (0)
#define PG8_LDB(dst, b, h) do { _Pragma("unroll") for (int n = 0; n < 2; ++n) _Pragma("unroll") for (int k = 0; k < 2; ++k) dst[n][k] = *(const LAS bf16x8*)(lds + PG8_SB(b, h) + boff + n * 2048 + k * 1024); } while (0)
#define PG8_MMA(ai, bj, At, Bt) do { __builtin_amdgcn_s_setprio(1); _Pragma("unroll") for (int m = 0; m < 4; ++m) _Pragma("unroll") for (int n = 0; n < 2; ++n) _Pragma("unroll") for (int k = 0; k < 2; ++k) \
        acc[ai][bj][m][n] = __builtin_amdgcn_mfma_f32_16x16x32_bf16(Bt[n][k], At[m][k], acc[ai][bj][m][n], 0, 0, 0); __builtin_amdgcn_s_setprio(0); } while (0)
#define PG8_WAIT_V(n) asm volatile("s_waitcnt vmcnt(" #n ")" ::: "memory")
#define PG8_WAIT_L(n) asm volatile("s_waitcnt lgkmcnt(" #n ")" ::: "memory")
#define PG8_BAR __builtin_amdgcn_s_barrier()
#define PG8_SCHED __builtin_amdgcn_sched_barrier(0)
    Unit cur, nxt; int ui = 0;
    if (!S.next(0, cur)) return;
    int nt = cur.nt;
    f32x4 acc[2][2][4][2];
#pragma unroll
    for (int a = 0; a < 2; ++a)
#pragma unroll
        for (int b = 0; b < 2; ++b)
#pragma unroll
            for (int m = 0; m < 4; ++m)
#pragma unroll
                for (int n = 0; n < 2; ++n) acc[a][b][m][n] = (f32x4){0.f, 0.f, 0.f, 0.f};
    bf16x8 At[4][2], B0[2][2], B1[2][2];
    const char* cA = S.a_base(cur); const char* cB = S.b_base(cur);
    PG8_STAGE(PG8_SB(0, 0), cB, voffB); PG8_STAGE(PG8_SB(0, 1), cB + hstepB, voffB); PG8_STAGE(PG8_SA(0, 0), cA, voffA[0]); PG8_STAGE(PG8_SA(0, 1), cA, voffA[1]);
    if (wr == 1) PG8_BAR;
    PG8_WAIT_V(2); PG8_BAR;
    PG8_STAGE(PG8_SB(1, 0), cB + kstep, voffB); PG8_STAGE(PG8_SA(1, 0), cA + kstep, voffA[0]); PG8_STAGE(PG8_SB(1, 1), cB + hstepB + kstep, voffB);
    PG8_WAIT_V(6); PG8_BAR;
    for (;;) {
        const bool has_next = S.next(ui + 1, nxt);
        const char* nA = has_next ? S.a_base(nxt) : cA; const char* nB = has_next ? S.b_base(nxt) : cB;
        if constexpr (GATHER) { if (has_next) PG8_GATHER_OFFS(voffAn, ui + 1); else { _Pragma("unroll") for (int h_ = 0; h_ < 2; ++h_) _Pragma("unroll") for (int i_ = 0; i_ < 2; ++i_) voffAn[h_][i_] = voffA[h_][i_]; } }
        for (int t = 0; t < nt; t += 2) {
            const bool last = (t == nt - 2);
            const char* a1 = cA + (size_t)(t + 1) * kstep;
            const char* a2 = last ? nA : cA + (size_t)(t + 2) * kstep; const char* b2 = last ? nB : cB + (size_t)(t + 2) * kstep;
            const char* a3 = a2 + kstep; const char* b3 = b2 + kstep;
            unsigned vs0[2], vs1[2];
            if constexpr (GATHER) { _Pragma("unroll") for (int i_ = 0; i_ < 2; ++i_) { vs0[i_] = last ? voffAn[0][i_] : voffA[0][i_]; vs1[i_] = last ? voffAn[1][i_] : voffA[1][i_]; } }
            else { _Pragma("unroll") for (int i_ = 0; i_ < 2; ++i_) { vs0[i_] = voffA[0][i_]; vs1[i_] = voffA[1][i_]; } }
            PG8_LDB(B0, 0, 0); PG8_LDB(B1, 0, 1); PG8_SCHED; PG8_LDA(At, 0, 0); PG8_STAGE(PG8_SA(1, 1), a1, voffA[1]);
            PG8_WAIT_V(8); PG8_WAIT_L(0); PG8_BAR; PG8_MMA(0, 0, At, B0); PG8_MMA(0, 1, At, B1); PG8_BAR; PG8_SCHED;
            PG8_LDA(At, 0, 1); PG8_STAGE(PG8_SB(0, 0), b2, voffB); PG8_STAGE(PG8_SB(0, 1), b2 + hstepB, voffB); PG8_STAGE(PG8_SA(0, 0), a2, vs0);
            PG8_WAIT_V(8); PG8_WAIT_L(0); PG8_BAR; PG8_MMA(1, 0, At, B0); PG8_MMA(1, 1, At, B1); PG8_BAR; PG8_SCHED;
            PG8_LDB(B0, 1, 0); PG8_LDB(B1, 1, 1); PG8_SCHED; PG8_LDA(At, 1, 0); PG8_STAGE(PG8_SA(0, 1), a2, vs1);
            PG8_WAIT_V(8); PG8_WAIT_L(0); PG8_BAR; PG8_MMA(0, 0, At, B0); PG8_MMA(0, 1, At, B1); PG8_BAR; PG8_SCHED;
            PG8_LDA(At, 1, 1); PG8_STAGE(PG8_SB(1, 0), b3, voffB); PG8_STAGE(PG8_SB(1, 1), b3 + hstepB, voffB); PG8_STAGE(PG8_SA(1, 0), a3, vs0);
            PG8_WAIT_V(8); PG8_WAIT_L(0); PG8_BAR; PG8_MMA(1, 0, At, B0); PG8_MMA(1, 1, At, B1); PG8_BAR; PG8_SCHED;
        }
        if constexpr (ALIGN_EPI) { if (wr == 0) PG8_BAR; }
        E(acc, cur, wr, wc, fr, fq);
        if (!has_next) break;
#pragma unroll
        for (int a = 0; a < 2; ++a)
#pragma unroll
            for (int b = 0; b < 2; ++b)
#pragma unroll
                for (int m = 0; m < 4; ++m)
#pragma unroll
                    for (int n = 0; n < 2; ++n) acc[a][b][m][n] = (f32x4){0.f, 0.f, 0.f, 0.f};
        cur = nxt; cA = nA; cB = nB; ++ui; nt = cur.nt;
        PG8_LANECONST();
        if constexpr (GATHER) PG8_GATHER_OFFS(voffA, ui);
        if constexpr (ALIGN_EPI) { if (wr == 1) PG8_BAR; }
    }
    PG8_WAIT_V(0);
    if constexpr (!ALIGN_EPI) { if (wr == 0) PG8_BAR; }
    PG8_BAR;
#undef PG8_LANECONST
#undef PG8_GATHER_OFFS
#undef PG8_SA
#undef PG8_SB
#undef PG8_STAGE
#undef PG8_LDA
#undef PG8_LDB
#undef PG8_MMA
#undef PG8_WAIT_V
#undef PG8_WAIT_L
#undef PG8_BAR
#undef PG8_SCHED
}
}

using pg8::Unit;
__device__ __forceinline__ int bidx_of_tile(int pm) { return pm < (NLAT / 256) ? (pm >> 4) : NB; }

struct EpiZ {
    static constexpr bool PERM = true;
    bf16_t* Z; float* SSQ;
    __device__ __forceinline__ void operator()(const f32x4 (&acc)[2][2][4][2], const Unit& u, int wr, int wc, int fr, int fq) const {
        const int row0 = u.pm * 256 + wr * 64 + fr, col0 = u.pn * 256 + wc * 32 + 8 * fq;
#pragma unroll
        for (int ai = 0; ai < 2; ++ai)
#pragma unroll
            for (int m = 0; m < 4; ++m) { const int row = row0 + ai * 128 + m * 16;
#pragma unroll
                for (int bj = 0; bj < 2; ++bj) { const f32x4 v0 = acc[ai][bj][m][0], v1 = acc[ai][bj][m][1];
                    u32x4 w; w.x = cvt_pk_bf16(v0[0], v0[1]); w.y = cvt_pk_bf16(v0[2], v0[3]); w.z = cvt_pk_bf16(v1[0], v1[1]); w.w = cvt_pk_bf16(v1[2], v1[3]);
                    *(GAS u32x4*)(Z + (size_t)row * ZW + col0 + bj * 128) = w;
                    float s = (v0[0] * v0[0] + v0[1] * v0[1]) + (v0[2] * v0[2] + v0[3] * v0[3]) + (v1[0] * v1[0] + v1[1] * v1[1]) + (v1[2] * v1[2] + v1[3] * v1[3]);
                    s += __shfl_xor(s, 16); s += __shfl_xor(s, 32);
                    if (fq == 0) ((GAS float*)SSQ)[(size_t)row * 24 + u.pn * 8 + bj * 4 + wc] = s; } }
    }
};
__device__ __forceinline__ float rstd_q_of(const float* SSQ, int row) { const GAS f32x4* p = (const GAS f32x4*)(SSQ + (size_t)row * 24); const f32x4 a = p[0], b = p[1], c = p[2];
    const float s = ((a[0] + a[1]) + (a[2] + a[3])) + ((b[0] + b[1]) + (b[2] + b[3])) + ((c[0] + c[1]) + (c[2] + c[3])); return rsqrtf(s * (1.0f / QLORA) + EPS); }
__device__ __forceinline__ float rstd_kv_of(const float* SSQ, int row) { const GAS f32x4* p = (const GAS f32x4*)(SSQ + (size_t)row * 24); const f32x4 a = p[3], b = p[4];
    const float s = ((a[0] + a[1]) + (a[2] + a[3])) + ((b[0] + b[1]) + (b[2] + b[3])); return rsqrtf(s * (1.0f / KVLORA) + EPS); }

struct EpiQ {
    static constexpr bool PERM = true;
    bf16_t* Q; const float* SSQ; const f32x2* ROPE_T;
    __device__ __forceinline__ void operator()(const f32x4 (&acc)[2][2][4][2], const Unit& u, int wr, int wc, int fr, int fq) const {
        const int row0 = u.pm * 256 + wr * 64 + fr, col0 = u.pn * 256 + wc * 32 + 8 * fq;
        const bool latent = u.pm < (NLAT / 256);
#pragma unroll
        for (int ai = 0; ai < 2; ++ai) {
            float rs4[4];
#pragma unroll
            for (int m = 0; m < 4; ++m) rs4[m] = rstd_q_of(SSQ, row0 + ai * 128 + m * 16) * ATT_C2;
#pragma unroll
            for (int m = 0; m < 4; ++m) { const int row = row0 + ai * 128 + m * 16; const float rs = rs4[m]; const int t = row & (SEQ - 1);
#pragma unroll
                for (int bj = 0; bj < 2; ++bj) { const int cb = col0 + bj * 128; const int d0 = cb % QKD;
                    float v[8];
#pragma unroll
                    for (int j = 0; j < 4; ++j) { v[j] = acc[ai][bj][m][0][j] * rs; v[4 + j] = acc[ai][bj][m][1][j] * rs; }
                    if (latent && d0 >= 64) {
                        const int dd = d0 - 64; const float pos = (float)((dd >> 4) == 0 ? (t >> 6) : (t & 63));
                        const float pr = pos * ((dd & 8) ? 0.01f : 1.0f) * 0.15915494309189535f;
                        const float r0 = pr, r1 = pr * 0.31622776601683794f, r2 = pr * 0.1f, r3 = pr * 0.031622776601683794f;
                        const float c0 = __builtin_amdgcn_cosf(r0), s0 = __builtin_amdgcn_sinf(r0), c1 = __builtin_amdgcn_cosf(r1), s1 = __builtin_amdgcn_sinf(r1);
                        const float c2 = __builtin_amdgcn_cosf(r2), s2 = __builtin_amdgcn_sinf(r2), c3 = __builtin_amdgcn_cosf(r3), s3 = __builtin_amdgcn_sinf(r3);
                        float x1, x2;
                        x1 = v[0]; x2 = v[1]; v[0] = x1 * c0 - x2 * s0; v[1] = x2 * c0 + x1 * s0;
                        x1 = v[2]; x2 = v[3]; v[2] = x1 * c1 - x2 * s1; v[3] = x2 * c1 + x1 * s1;
                        x1 = v[4]; x2 = v[5]; v[4] = x1 * c2 - x2 * s2; v[5] = x2 * c2 + x1 * s2;
                        x1 = v[6]; x2 = v[7]; v[6] = x1 * c3 - x2 * s3; v[7] = x2 * c3 + x1 * s3; }
                    u32x4 w; w.x = cvt_pk_bf16(v[0], v[1]); w.y = cvt_pk_bf16(v[2], v[3]); w.z = cvt_pk_bf16(v[4], v[5]); w.w = cvt_pk_bf16(v[6], v[7]);
                    *(GAS u32x4*)(Q + (size_t)row * (NHEAD * QKD) + cb) = w; } }
            asm volatile("" ::: "memory"); }
    }
};
struct EpiKV {
    static constexpr bool PERM = true;
    bf16_t* Kb; bf16_t* Vb; const float* SSQ;
    __device__ __forceinline__ void operator()(const f32x4 (&acc)[2][2][4][2], const Unit& u, int wr, int wc, int fr, int fq) const {
        const int row0 = u.pm * 256 + wr * 64 + fr;
#pragma unroll
        for (int ai = 0; ai < 2; ++ai) { float rs4[4];
#pragma unroll
            for (int m = 0; m < 4; ++m) rs4[m] = rstd_kv_of(SSQ, row0 + ai * 128 + m * 16);
#pragma unroll
            for (int m = 0; m < 4; ++m) { const int row = row0 + ai * 128 + m * 16; const float rs = rs4[m];
#pragma unroll
                for (int bj = 0; bj < 2; ++bj) { const int head = u.pn * 2 + bj; const int j0 = wc * 32 + 8 * fq;
                    const f32x4 v0 = acc[ai][bj][m][0] * rs, v1 = acc[ai][bj][m][1] * rs;
                    u32x4 w; w.x = cvt_pk_bf16(v0[0], v0[1]); w.y = cvt_pk_bf16(v0[2], v0[3]); w.z = cvt_pk_bf16(v1[0], v1[1]); w.w = cvt_pk_bf16(v1[2], v1[3]);
                    bf16_t* dst = ((j0 < 64) ? Kb : Vb) + (size_t)row * (NHEAD * VD) + head * VD + (j0 & 63);
                    *(u32x4*)dst = w; } }
            asm volatile("" ::: "memory"); }
    }
};
__device__ __forceinline__ f32x4 bf4_lo(const u32x4 w) { return (f32x4){__builtin_bit_cast(float, w.x << 16), __builtin_bit_cast(float, w.x & 0xffff0000u), __builtin_bit_cast(float, w.y << 16), __builtin_bit_cast(float, w.y & 0xffff0000u)}; }
__device__ __forceinline__ f32x4 bf4_hi(const u32x4 w) { return (f32x4){__builtin_bit_cast(float, w.z << 16), __builtin_bit_cast(float, w.z & 0xffff0000u), __builtin_bit_cast(float, w.w << 16), __builtin_bit_cast(float, w.w & 0xffff0000u)}; }
template <bool PS> struct EpiResidT {
    static constexpr bool PERM = true;
    bf16_t* X; const float* gate; const float* pscale; float* SLAB;
    __device__ __forceinline__ void operator()(const f32x4 (&acc)[2][2][4][2], const Unit& u, int wr, int wc, int fr, int fq) const {
        const int row0 = u.pm * 256 + wr * 64 + fr, col0 = u.pn * 256 + wc * 32 + 8 * fq;
        const float* g = gate + (size_t)bidx_of_tile(u.pm) * 6144;
        f32x4 gv[2][2];
#pragma unroll
        for (int bj = 0; bj < 2; ++bj)
#pragma unroll
            for (int n = 0; n < 2; ++n) { gv[bj][n] = *(const GAS f32x4*)(g + col0 + bj * 128 + n * 4); if (PS) gv[bj][n] = gv[bj][n] * *(const GAS f32x4*)(pscale + col0 + bj * 128 + n * 4); }
        if (u.slab >= 0) {
            float* sp = SLAB + ((size_t)u.slab * 256 + wr * 64 + fr) * 256 + wc * 32 + 8 * fq;
#pragma unroll
            for (int ai = 0; ai < 2; ++ai)
#pragma unroll
                for (int m = 0; m < 4; ++m)
#pragma unroll
                    for (int bj = 0; bj < 2; ++bj)
#pragma unroll
                        for (int n = 0; n < 2; ++n) *(GAS f32x4*)(sp + (size_t)(ai * 128 + m * 16) * 256 + bj * 128 + n * 4) = gv[bj][n] * acc[ai][bj][m][n];
            return; }
        u32x4 xv[2][4][2];
#pragma unroll
        for (int ai = 0; ai < 2; ++ai)
#pragma unroll
            for (int m = 0; m < 4; ++m)
#pragma unroll
                for (int bj = 0; bj < 2; ++bj) xv[ai][m][bj] = *(const GAS u32x4*)(X + (size_t)(row0 + ai * 128 + m * 16) * DM + col0 + bj * 128);
#pragma unroll
        for (int ai = 0; ai < 2; ++ai)
#pragma unroll
            for (int m = 0; m < 4; ++m)
#pragma unroll
                for (int bj = 0; bj < 2; ++bj) { const f32x4 a = bf4_lo(xv[ai][m][bj]) + gv[bj][0] * acc[ai][bj][m][0], b = bf4_hi(xv[ai][m][bj]) + gv[bj][1] * acc[ai][bj][m][1];
                    u32x4 w; w.x = cvt_pk_bf16(a[0], a[1]); w.y = cvt_pk_bf16(a[2], a[3]); w.z = cvt_pk_bf16(b[0], b[1]); w.w = cvt_pk_bf16(b[2], b[3]);
                    *(GAS u32x4*)(X + (size_t)(row0 + ai * 128 + m * 16) * DM + col0 + bj * 128) = w; }
    }
};
typedef EpiResidT<false> EpiResid;
struct EpiSwiGLU {
    static constexpr bool PERM = true;
    bf16_t* ACT;
    __device__ __forceinline__ void operator()(const f32x4 (&acc)[2][2][4][2], const Unit& u, int wr, int wc, int fr, int fq) const {
        const int row0 = u.pm * 256 + wr * 64 + fr, col0 = u.pn * 128 + wc * 32 + 8 * fq;
#pragma unroll
        for (int ai = 0; ai < 2; ++ai)
#pragma unroll
            for (int m = 0; m < 4; ++m) { float o[8];
#pragma unroll
                for (int n = 0; n < 2; ++n)
#pragma unroll
                    for (int j = 0; j < 4; ++j) o[n * 4 + j] = siluf_(acc[ai][0][m][n][j]) * acc[ai][1][m][n][j];
                u32x4 w; w.x = cvt_pk_bf16(o[0], o[1]); w.y = cvt_pk_bf16(o[2], o[3]); w.z = cvt_pk_bf16(o[4], o[5]); w.w = cvt_pk_bf16(o[6], o[7]);
                *(GAS u32x4*)(ACT + (size_t)(row0 + ai * 128 + m * 16) * FFN + col0) = w; }
    }
};
struct EpiGLU {
    static constexpr bool PERM = true;
    bf16_t* X; const float* gate;
    __device__ __forceinline__ void operator()(const f32x4 (&acc)[2][2][4][2], const Unit& u, int wr, int wc, int fr, int fq) const {
        const int row0 = u.pm * 256 + wr * 64 + fr, col0 = u.pn * 128 + wc * 32 + 8 * fq;
        const float* g = gate + (size_t)bidx_of_tile(u.pm) * 6144;
        f32x4 gv[2];
#pragma unroll
        for (int n = 0; n < 2; ++n) gv[n] = *(const GAS f32x4*)(g + col0 + n * 4);
        u32x4 xv[2][4];
#pragma unroll
        for (int ai = 0; ai < 2; ++ai)
#pragma unroll
            for (int m = 0; m < 4; ++m) xv[ai][m] = *(const GAS u32x4*)(X + (size_t)(row0 + ai * 128 + m * 16) * DM + col0);
#pragma unroll
        for (int ai = 0; ai < 2; ++ai)
#pragma unroll
            for (int m = 0; m < 4; ++m) { f32x4 o0, o1;
#pragma unroll
                for (int j = 0; j < 4; ++j) { o0[j] = acc[ai][0][m][0][j] * sigmoidf_(acc[ai][1][m][0][j]); o1[j] = acc[ai][0][m][1][j] * sigmoidf_(acc[ai][1][m][1][j]); }
                const f32x4 a = bf4_lo(xv[ai][m]) + gv[0] * o0, b = bf4_hi(xv[ai][m]) + gv[1] * o1;
                u32x4 w; w.x = cvt_pk_bf16(a[0], a[1]); w.y = cvt_pk_bf16(a[2], a[3]); w.z = cvt_pk_bf16(b[0], b[1]); w.w = cvt_pk_bf16(b[2], b[3]);
                *(GAS u32x4*)(X + (size_t)(row0 + ai * 128 + m * 16) * DM + col0) = w; }
    }
};
struct EpiBf16 {
    static constexpr bool PERM = true;
    bf16_t* O; int ldc; float* SLAB;
    __device__ __forceinline__ void operator()(const f32x4 (&acc)[2][2][4][2], const Unit& u, int wr, int wc, int fr, int fq) const {
        const int row0 = u.pm * 256 + wr * 64 + fr, col0 = u.pn * 256 + wc * 32 + 8 * fq;
        if (u.slab >= 0) { float* sp = SLAB + ((size_t)u.slab * 256 + wr * 64 + fr) * 256 + wc * 32 + 8 * fq;
#pragma unroll
            for (int ai = 0; ai < 2; ++ai)
#pragma unroll
                for (int m = 0; m < 4; ++m)
#pragma unroll
                    for (int bj = 0; bj < 2; ++bj) { float* q = sp + (size_t)(ai * 128 + m * 16) * 256 + bj * 128; *(GAS f32x4*)q = acc[ai][bj][m][0]; *(GAS f32x4*)(q + 4) = acc[ai][bj][m][1]; }
            return; }
#pragma unroll
        for (int ai = 0; ai < 2; ++ai)
#pragma unroll
            for (int m = 0; m < 4; ++m)
#pragma unroll
                for (int bj = 0; bj < 2; ++bj) { const f32x4 v0 = acc[ai][bj][m][0], v1 = acc[ai][bj][m][1];
                    u32x4 w; w.x = cvt_pk_bf16(v0[0], v0[1]); w.y = cvt_pk_bf16(v0[2], v0[3]); w.z = cvt_pk_bf16(v1[0], v1[1]); w.w = cvt_pk_bf16(v1[2], v1[3]);
                    *(GAS u32x4*)(O + (size_t)(row0 + ai * 128 + m * 16) * ldc + col0 + bj * 128) = w; }
    }
};

namespace att {
constexpr int KSLOT = 12288, VSLOT = 8192;
constexpr int NSK = 4, NSV = 4;
constexpr int LDS_K = 0, LDS_V = NSK * KSLOT, LDS_WS = LDS_V + NSV * VSLOT, LDS_OST = LDS_WS + 8 * 64 * 4, LDS_BYTES = LDS_OST + 8 * 4096;
static_assert(LDS_BYTES <= 131072, "attention LDS");
constexpr float C2 = 0.10206207261596577f * 1.4426950408889634f;
constexpr float THRL = 8.f;
#define SBAR() __builtin_amdgcn_sched_barrier(0)
__device__ __forceinline__ int crow(int r, int hi) { return (r & 3) + 8 * (r >> 2) + 4 * hi; }
__device__ __forceinline__ float max3f(float a, float b, float c) { return __builtin_fmaxf(__builtin_fmaxf(a, b), c); }
__device__ __forceinline__ float rowmax32(const f32x16& p0, const f32x16& p1) {
    float a = max3f(p0[0], p0[1], p1[0]), b = max3f(p0[2], p0[3], p1[1]); a = max3f(a, p1[2], p1[3]);
#pragma unroll
    for (int r = 4; r < 16; r += 4) { a = max3f(a, p0[r], p0[r + 1]); b = max3f(b, p0[r + 2], p0[r + 3]); a = max3f(a, p1[r], p1[r + 1]); b = max3f(b, p1[r + 2], p1[r + 3]); }
    float m = __builtin_fmaxf(a, b);
    auto rr = __builtin_amdgcn_permlane32_swap(__float_as_uint(m), __float_as_uint(m), false, false);
    return __builtin_fmaxf(__uint_as_float(rr[0]), __uint_as_float(rr[1]));
}
__device__ __forceinline__ void wait_bar(int n) {
    switch (n) {
        case 0: asm volatile("s_waitcnt vmcnt(0) lgkmcnt(0)\n\ts_barrier" ::: "memory"); break;
        case 1: asm volatile("s_waitcnt vmcnt(1) lgkmcnt(0)\n\ts_barrier" ::: "memory"); break;
        case 2: asm volatile("s_waitcnt vmcnt(2) lgkmcnt(0)\n\ts_barrier" ::: "memory"); break;
        case 3: asm volatile("s_waitcnt vmcnt(3) lgkmcnt(0)\n\ts_barrier" ::: "memory"); break;
        case 4: asm volatile("s_waitcnt vmcnt(4) lgkmcnt(0)\n\ts_barrier" ::: "memory"); break;
        case 5: asm volatile("s_waitcnt vmcnt(5) lgkmcnt(0)\n\ts_barrier" ::: "memory"); break;
        default: asm volatile("s_waitcnt vmcnt(6) lgkmcnt(0)\n\ts_barrier" ::: "memory"); break;
    }
}
#define WAITBAR(n) wait_bar(n)
__device__ __forceinline__ s16x4 vtr(const LAS unsigned char* p) { typedef short v4i16_t __attribute__((ext_vector_type(4))); return __builtin_bit_cast(s16x4, __builtin_amdgcn_ds_read_tr16_b64_v4i16((LAS v4i16_t*)p)); }

__device__ __forceinline__ void attn_unit(const bf16_t* __restrict__ Qb, const bf16_t* __restrict__ Kb, const bf16_t* __restrict__ Vb, bf16_t* __restrict__ Ob,
                                          const bf16_t* __restrict__ KRb, int qrow0, int kctx0, int klat0, int h, int NT, LAS unsigned char* lds) {
    int tid_ = threadIdx.x; asm volatile("" : "+v"(tid_));
    const int tid = tid_, lane = tid & 63, r32 = lane & 31, hi = lane >> 5; const int wid = __builtin_amdgcn_readfirstlane(tid >> 6);
    LAS float* wsf = (LAS float*)(lds + LDS_WS) + wid * 64;
    const int nk = wid < 4 ? 2 : 1;
    const bf16_t* ksrc = Kb + (size_t)lane * (NHEAD * VD) + h * VD + wid * 8;
    const bf16_t* krsrc = KRb + (size_t)lane * 32 + (wid & 3) * 8;
    const bf16_t* vsrc = Vb + (size_t)(16 * (wid & 3) + (lane >> 2)) * (NHEAD * VD) + h * VD + (wid >> 2) * 32 + (lane & 3) * 8;
#define KROW(t) ((t) < 4 ? kctx0 + (t) * 64 : klat0 + ((t) - 4) * 64)
#define DMA_K(t) do { const size_t kr_ = (size_t)KROW(t); LAS unsigned char* sl_ = lds + LDS_K + ((t) % NSK) * KSLOT; \
        __builtin_amdgcn_global_load_lds((const unsigned*)(ksrc + kr_ * (NHEAD * VD)), (LAS unsigned*)(sl_ + wid * 1024), 16, 0, 0); \
        if (wid < 4) __builtin_amdgcn_global_load_lds((const unsigned*)(krsrc + kr_ * 32), (LAS unsigned*)(sl_ + (wid + 8) * 1024), 16, 0, 0); } while (0)
#define DMA_V(t) do { const size_t ro_ = (size_t)KROW(t) * (NHEAD * VD); __builtin_amdgcn_global_load_lds((const unsigned*)(vsrc + ro_), (LAS unsigned*)(lds + LDS_V + ((t) % NSV) * VSLOT + wid * 1024), 16, 0, 0); } while (0)
    const LAS unsigned char* kp0 = lds + LDS_K + hi * 1024 + r32 * 16;
    const LAS unsigned char* vp0 = lds + LDS_V + ((lane >> 4) & 1) * 32 + (lane & 3) * 8 + (4 * hi + ((lane & 15) >> 2)) * 64;
    float mhat = 0.f; f32x16 o[3]; o[0] = f32x16{}; o[1] = f32x16{}; o[2] = f32x16{}; f32x16 negm = f32x16{}; asm volatile("" : "+v"(negm));
    const bf16x8 ones8 = {0x3F80, 0x3F80, 0x3F80, 0x3F80, 0x3F80, 0x3F80, 0x3F80, 0x3F80};
    bool resc = false;
    DMA_K(0); DMA_V(0); DMA_K(1); DMA_V(1); DMA_K(2);
    static_assert(NSK == 4 && NSV == 4, "prologue issues K0..K2, V0..V1");
    bf16x8 qr[6];
    { const bf16_t* Qw = Qb + (size_t)(qrow0 + wid * 32 + r32) * (NHEAD * QKD) + h * QKD + hi * 8;
#pragma unroll
      for (int d0 = 0; d0 < 6; ++d0) qr[d0] = *(const GAS bf16x8*)(Qw + d0 * 16); }
    asm volatile("" : "+v"(qr[0]), "+v"(qr[1]), "+v"(qr[2]), "+v"(qr[3]), "+v"(qr[4]), "+v"(qr[5]));
    WAITBAR(0);
    f32x16 pA0, pA1, pB0, pB1;
#define QKT(C0, C1, t) do { const LAS unsigned char* kb_ = kp0 + ((t) % NSK) * KSLOT; \
        _Pragma("unroll") for (int d0 = 0; d0 < 6; ++d0) { const bf16x8 b0 = *(const LAS bf16x8*)(kb_ + d0 * 2048), b1 = *(const LAS bf16x8*)(kb_ + d0 * 2048 + 512); \
            if (d0 == 0) { C0 = __builtin_amdgcn_mfma_f32_32x32x16_bf16(b0, qr[0], negm, 0, 0, 0); C1 = __builtin_amdgcn_mfma_f32_32x32x16_bf16(b1, qr[0], negm, 0, 0, 0); } \
            else { C0 = __builtin_amdgcn_mfma_f32_32x32x16_bf16(b0, qr[d0], C0, 0, 0, 0); C1 = __builtin_amdgcn_mfma_f32_32x32x16_bf16(b1, qr[d0], C1, 0, 0, 0); } } } while (0)
#define DECIDE(C0, C1, FIRST) do { float rm_ = rowmax32(C0, C1); resc = false; \
        if ((FIRST) || __builtin_expect(__any(rm_ > THRL), 0)) { const float dl_ = (FIRST) ? rm_ : __builtin_fmaxf(rm_, 0.f); mhat += dl_; \
            _Pragma("unroll") for (int r = 0; r < 16; ++r) { C0[r] -= dl_; C1[r] -= dl_; } \
            _Pragma("unroll") for (int r = 0; r < 16; ++r) negm[r] = -mhat; asm volatile("" : "+v"(negm)); \
            if (!(FIRST)) { const float f_ = __builtin_amdgcn_exp2f(-dl_); if (hi == 0) wsf[r32] = f_; resc = true; } } } while (0)
#define EXPS(C0, C1) do { _Pragma("unroll") for (int r = 0; r < 16; ++r) { C0[r] = __builtin_amdgcn_exp2f(C0[r]); C1[r] = __builtin_amdgcn_exp2f(C1[r]); } } while (0)
#define RESC() do { if (resc) { asm volatile("s_waitcnt lgkmcnt(0)" ::: "memory"); \
        _Pragma("unroll") for (int d_ = 0; d_ < 3; ++d_) _Pragma("unroll") for (int r = 0; r < 16; ++r) o[d_][r] *= wsf[crow(r, hi)]; } } while (0)
#define PV(P0, P1, t) do { u32x4 w0_, w1_, w2_, w3_; \
        w0_ = (u32x4){cvt_pk_bf16(P0[0], P0[1]), cvt_pk_bf16(P0[2], P0[3]), cvt_pk_bf16(P0[4], P0[5]), cvt_pk_bf16(P0[6], P0[7])}; \
        w1_ = (u32x4){cvt_pk_bf16(P0[8], P0[9]), cvt_pk_bf16(P0[10], P0[11]), cvt_pk_bf16(P0[12], P0[13]), cvt_pk_bf16(P0[14], P0[15])}; \
        w2_ = (u32x4){cvt_pk_bf16(P1[0], P1[1]), cvt_pk_bf16(P1[2], P1[3]), cvt_pk_bf16(P1[4], P1[5]), cvt_pk_bf16(P1[6], P1[7])}; \
        w3_ = (u32x4){cvt_pk_bf16(P1[8], P1[9]), cvt_pk_bf16(P1[10], P1[11]), cvt_pk_bf16(P1[12], P1[13]), cvt_pk_bf16(P1[14], P1[15])}; \
        const LAS unsigned char* vp_ = vp0 + ((t) % NSV) * VSLOT; \
        _Pragma("unroll") for (int d0 = 0; d0 < 2; ++d0) { \
            const s16x4 l0 = vtr(vp_ + d0 * 4096), h0 = vtr(vp_ + d0 * 4096 + 512), l1 = vtr(vp_ + d0 * 4096 + 1024), h1 = vtr(vp_ + d0 * 4096 + 1536); \
            const s16x4 l2 = vtr(vp_ + d0 * 4096 + 2048), h2 = vtr(vp_ + d0 * 4096 + 2560), l3 = vtr(vp_ + d0 * 4096 + 3072), h3 = vtr(vp_ + d0 * 4096 + 3584); \
            o[d0] = __builtin_amdgcn_mfma_f32_32x32x16_bf16(__builtin_bit_cast(bf16x8, w0_), (bf16x8){l0[0], l0[1], l0[2], l0[3], h0[0], h0[1], h0[2], h0[3]}, o[d0], 0, 0, 0); \
            o[d0] = __builtin_amdgcn_mfma_f32_32x32x16_bf16(__builtin_bit_cast(bf16x8, w1_), (bf16x8){l1[0], l1[1], l1[2], l1[3], h1[0], h1[1], h1[2], h1[3]}, o[d0], 0, 0, 0); \
            o[d0] = __builtin_amdgcn_mfma_f32_32x32x16_bf16(__builtin_bit_cast(bf16x8, w2_), (bf16x8){l2[0], l2[1], l2[2], l2[3], h2[0], h2[1], h2[2], h2[3]}, o[d0], 0, 0, 0); \
            o[d0] = __builtin_amdgcn_mfma_f32_32x32x16_bf16(__builtin_bit_cast(bf16x8, w3_), (bf16x8){l3[0], l3[1], l3[2], l3[3], h3[0], h3[1], h3[2], h3[3]}, o[d0], 0, 0, 0); } \
        o[2] = __builtin_amdgcn_mfma_f32_32x32x16_bf16(__builtin_bit_cast(bf16x8, w0_), ones8, o[2], 0, 0, 0); o[2] = __builtin_amdgcn_mfma_f32_32x32x16_bf16(__builtin_bit_cast(bf16x8, w1_), ones8, o[2], 0, 0, 0); \
        o[2] = __builtin_amdgcn_mfma_f32_32x32x16_bf16(__builtin_bit_cast(bf16x8, w2_), ones8, o[2], 0, 0, 0); o[2] = __builtin_amdgcn_mfma_f32_32x32x16_bf16(__builtin_bit_cast(bf16x8, w3_), ones8, o[2], 0, 0, 0); } while (0)
#define ISSUED(s_) (((s_) + NSK - 1 < NT ? nk : 0) + ((s_) + NSV - 2 < NT ? 1 : 0))
#define STEP_L(C0, C1, P0, P1, t, FIRST) do { \
        if ((t) + NSK - 1 < NT) DMA_K((t) + NSK - 1); if ((t) + NSV - 2 < NT) DMA_V((t) + NSV - 2); \
        QKT(C0, C1, t); \
        if (!(FIRST)) PV(P0, P1, (t) - 1); \
        DECIDE(C0, C1, FIRST); EXPS(C0, C1); \
        WAITBAR(ISSUED(t) + ((t) >= 1 ? ISSUED((t) - 1) : 0)); \
        RESC(); } while (0)
#define STEP_T(C0, C1, P0, P1, t, FIRST, SECOND) do { \
        if ((t) + NSK - 1 < NT) DMA_K((t) + NSK - 1); if ((t) + NSV - 2 < NT) DMA_V((t) + NSV - 2); \
        if (!(FIRST)) { DECIDE(P0, P1, SECOND); EXPS(P0, P1); RESC(); } \
        QKT(C0, C1, t); \
        if (!(FIRST)) PV(P0, P1, (t) - 1); \
        WAITBAR(ISSUED(t) + ((t) >= 1 ? ISSUED((t) - 1) : 0)); } while (0)
    if (wid < 4) {
        STEP_L(pA0, pA1, pB0, pB1, 0, true);
        STEP_L(pB0, pB1, pA0, pA1, 1, false);
        for (int t = 2; t + 1 < NT; t += 2) { STEP_L(pA0, pA1, pB0, pB1, t, false); STEP_L(pB0, pB1, pA0, pA1, t + 1, false); }
        PV(pB0, pB1, NT - 1);
    } else {
        STEP_T(pA0, pA1, pB0, pB1, 0, true, false);
        STEP_T(pB0, pB1, pA0, pA1, 1, false, true);
        for (int t = 2; t + 1 < NT; t += 2) { STEP_T(pA0, pA1, pB0, pB1, t, false, false); STEP_T(pB0, pB1, pA0, pA1, t + 1, false, false); }
        DECIDE(pB0, pB1, false); EXPS(pB0, pB1); RESC();
        PV(pB0, pB1, NT - 1);
    }
    float rli[16];
#pragma unroll
    for (int r = 0; r < 16; ++r) rli[r] = __builtin_amdgcn_rcpf(o[2][r]);
    { LAS bf16_t* stg = (LAS bf16_t*)(lds + LDS_OST) + wid * 2048;
#pragma unroll
      for (int r = 0; r < 16; ++r) { const int orow = crow(r, hi);
#pragma unroll
          for (int d0 = 0; d0 < 2; ++d0) stg[orow * 64 + d0 * 32 + r32] = (bf16_t)f2bf(o[d0][r] * rli[r]); }
      asm volatile("s_waitcnt lgkmcnt(0)" ::: "memory");
      bf16_t* Ow = Ob + (size_t)(qrow0 + wid * 32) * (NHEAD * VD) + h * VD;
#pragma unroll
      for (int i = 0; i < 4; ++i) { const int row = i * 8 + (lane >> 3), ch = lane & 7; const u32x4 v = *(const LAS u32x4*)(stg + row * 64 + ch * 8); *(GAS u32x4*)(Ow + (size_t)row * (NHEAD * VD) + ch * 8) = v; } }
    WAITBAR(0);
#undef KROW
#undef DMA_K
#undef DMA_V
#undef QKT
#undef DECIDE
#undef EXPS
#undef RESC
#undef PV
#undef STEP_L
#undef STEP_T
#undef ISSUED
}
#undef WAITBAR
#undef SBAR
}

#ifndef MOE_SPLIT
#define MOE_SPLIT false
#endif
constexpr size_t MiB = 1u << 20;
constexpr size_t WS_CTL = 0, CTL_ZERO_BYTES = 1 * MiB;
constexpr size_t CTL_BAR = 16384;
constexpr size_t CTL_MOD = 12 * MiB + 131072;
constexpr int MAX_LAUNCH_REGIONS = 64;
static_assert(CTL_BAR + (size_t)MAX_LAUNCH_REGIONS * 3456 * 4 <= CTL_ZERO_BYTES && CTL_MOD + 4 * 9 * 6144 * 4 <= 13 * MiB, "ctl");
constexpr size_t WS_ROPE = 1 * MiB;
constexpr size_t WS_S5FB = 2 * MiB;
constexpr size_t WS_S5MB = 6 * MiB;
constexpr size_t WS_S5EB = 8 * MiB;
constexpr size_t WS_S5L8 = 12 * MiB;
constexpr size_t WS_TOK = 13 * MiB;
constexpr size_t WS_S2R = 14 * MiB + 262144;
constexpr size_t WS_BLKCNT = 15 * MiB;
constexpr size_t WS_TILEE = WS_BLKCNT + 32768;
constexpr size_t WS_SSQ = 16 * MiB;
constexpr size_t WS_W = 20 * MiB;
constexpr size_t W_DQKV = 0;
constexpr size_t W_UQ = W_DQKV + (size_t)ZW * DM * 2;
constexpr size_t W_UKV = W_UQ + (size_t)1536 * QLORA * 2;
constexpr size_t W_O = W_UKV + (size_t)2048 * KVLORA * 2;
constexpr size_t W_MLA_SZ = W_O + (size_t)DM * DM * 2;
constexpr size_t W_GU_SZ = (size_t)2 * FFN * DM * 2, W_DN_SZ = (size_t)DM * FFN * 2, W_FFN_SZ = W_GU_SZ + W_DN_SZ;
constexpr size_t WO_MLA = 0, WO_FFN = WO_MLA + 2 * W_MLA_SZ, WO_MOE = WO_FFN + 2 * W_FFN_SZ, WO_GLU = WO_MOE + 16 * W_FFN_SZ, WO_POOL = WO_GLU + (size_t)2048 * DM * 2, WO_END = WO_POOL + (size_t)4 * 256 * 256 * 2;
constexpr size_t WS_X = WS_W + ((WO_END + MiB - 1) / MiB) * MiB;
constexpr size_t WS_H = WS_X + (size_t)MT * DM * 4;
constexpr size_t WS_BIG = WS_H + (size_t)MT * DM * 2;
constexpr size_t B_Z = 0, B_Q = B_Z + (size_t)MT * ZW * 2, B_K = B_Q + (size_t)MT * 1536 * 2, B_V = B_K + (size_t)MT * DM * 2, B_KR = B_V + (size_t)MT * DM * 2;
constexpr int MAXSLOT = 71680;
constexpr size_t B_XG = 0, B_ACTM = B_XG + (size_t)MAXSLOT * DM * 2, B_END = B_ACTM + (size_t)MAXSLOT * FFN * 2;
constexpr size_t B_G = 0, B_SIN = B_G + (size_t)MT * DM * 2;
constexpr size_t B_SLAB = (size_t)360 * MiB;
static_assert(B_KR + (size_t)MT * 64 <= B_SLAB && (size_t)MT * FFN * 2 <= B_SLAB && B_SLAB + (size_t)64 * MiB <= B_END && B_V + (size_t)MT * DM * 2 <= B_END && B_SIN + (size_t)64 * 2 * 8 * 544 * 128 * 2 <= B_END, "big");
constexpr size_t WS_SLAB2 = WS_BIG + B_END;
constexpr size_t WS_END = WS_SLAB2 + (size_t)64 * MiB;

struct Params { const float* in[33]; float* out; unsigned char* ws; int ph_lo, ph_hi, li, pad; };
struct Frame { LAS unsigned char* lds; int tid, lane, wave, blk, G, gw, NGW; unsigned char* ws; };
__device__ __forceinline__ Frame refresh(const Frame& F0) { Frame F = F0; int t = threadIdx.x; asm volatile("" : "+v"(t)); F.tid = t; F.lane = t & 63; return F; }
enum { I_X = 0, I_C, I_CTX, I_CCTX, I_N1G, I_N2G, I_ADAW, I_ADAB, I_FNG, I_WDQ, I_QNORM, I_WUQ, I_WDKV, I_KVNORM, I_WUKV, I_WO,
       I_S5ARE, I_S5AIM, I_S5LDT, I_S5BRE, I_S5BIM, I_S5CRE, I_S5CIM, I_S5D, I_S5GLU, I_POOLW, I_POOLS, I_FGU, I_FDN, I_MRW, I_MRB, I_MGU, I_MDN };

template <int SRC, bool COMB, int OUT, bool ROUTER, bool SLABS = false>
__device__ __forceinline__ void phase_rows(const Frame& F0, const Params& P, int nrows, const float* gain, const float* mod_shift  ,
                                           const float* mod_comb, int comb_rows, const float* w_router, const float* b_router, int route_rows, int slab_ntot = 0) {
    const Frame F = refresh(F0);
    LAS int* tailmap = (LAS int*)(F.lds + 1024); int slabS = 1, slabT = 0; const float* SLAB = (const float*)(F.ws + WS_BIG + B_SLAB);
    int mS = 1, mT = 0; const float* SLAB2 = (const float*)(F.ws + WS_SLAB2);
    if (COMB) { const int ntm_ = __builtin_amdgcn_readfirstlane(((const int*)(F.ws + WS_TILEE))[511]); pg8::Sched Sd; Sd.init(ntm_, 4, F.G, 0, FFN / 64, MOE_SPLIT, 8); mS = Sd.S; mT = Sd.nwg % F.G; const int Rr = Sd.nwg / F.G;
        for (int i = F.tid; i < ntm_ * 4; i += 512) tailmap[i] = 0;
        __syncthreads();
        if (mS > 1 && F.tid < mT) { pg8::Unit tu_; Sd.map((long)Rr * F.G + F.tid, tu_); tailmap[tu_.pm * 4 + tu_.pn] = F.tid + 1; }
        __syncthreads(); }
    if (SLABS) { pg8::Sched Sd; Sd.init(MT / 256, 4, F.G, 0, slab_ntot, true); slabS = Sd.S; slabT = Sd.nwg % F.G; const int Rr = Sd.nwg / F.G;
        for (int i = F.tid; i < (MT / 256) * 4; i += 512) tailmap[i] = 0;
        __syncthreads();
        if (slabS > 1 && F.tid < slabT) { pg8::Unit tu_; Sd.map((long)Rr * F.G + F.tid, tu_); tailmap[tu_.pm * 4 + tu_.pn] = F.tid + 1; }
        __syncthreads(); }
    bf16_t* X = (bf16_t*)(F.ws + WS_X); bf16_t* H = (bf16_t*)(F.ws + WS_H); const bf16_t* Y = (const bf16_t*)(F.ws + WS_BIG + B_XG);
    int* TOK = (int*)(F.ws + WS_TOK);
    LAS int* hist = (LAS int*)(F.lds);
    if (ROUTER) { if (F.tid < 8) hist[F.tid] = 0; __syncthreads(); }
    f32x4 gv[4];
#pragma unroll
    for (int j = 0; j < 4; ++j) gv[j] = *(const GAS f32x4*)(gain + 4 * F.lane + 256 * j);
    float wr[16][8];
    if (ROUTER) {
#pragma unroll
        for (int j = 0; j < 4; ++j)
#pragma unroll
            for (int q = 0; q < 4; ++q) { const int c = 4 * F.lane + 256 * j + q; const f32x4 wa = *(const GAS f32x4*)(w_router + (size_t)c * 8), wb = *(const GAS f32x4*)(w_router + (size_t)c * 8 + 4);
                wr[j * 4 + q][0] = wa[0]; wr[j * 4 + q][1] = wa[1]; wr[j * 4 + q][2] = wa[2]; wr[j * 4 + q][3] = wa[3]; wr[j * 4 + q][4] = wb[0]; wr[j * 4 + q][5] = wb[1]; wr[j * 4 + q][6] = wb[2]; wr[j * 4 + q][7] = wb[3]; } }
#define LOADROW(r_, dst, dstb, tkd) do { if (SRC == 1) { const float* src_ = (r_) < NLAT ? P.in[I_X] + (size_t)(r_) * DM : P.in[I_CTX] + (size_t)((r_) - NLAT) * DM; \
            _Pragma("unroll") for (int j = 0; j < 4; ++j) dst[j] = __builtin_nontemporal_load((const GAS f32x4*)(src_ + 4 * F.lane + 256 * j)); } \
        else { _Pragma("unroll") for (int j = 0; j < 4; ++j) dstb[j] = *(const GAS u32x2*)(X + (size_t)(r_) * DM + 4 * F.lane + 256 * j); } \
        if (COMB) { if ((r_) < comb_rows) tkd = *(const GAS u32x4*)(TOK + (size_t)(r_) * 8 + 4); } } while (0)
#define XSTORE(row_, j_, val_) do { u32x2 xw_; xw_.x = pk2((val_)[0], (val_)[1]); xw_.y = pk2((val_)[2], (val_)[3]); *(GAS u32x2*)(X + (size_t)(row_) * DM + 4 * F.lane + 256 * (j_)) = xw_; } while (0)
    f32x4 vn[4]; u32x2 vnb[4]; u32x4 tkn = {0u, 0u, 0u, 0u};
    if (F.gw < nrows) LOADROW(F.gw, vn, vnb, tkn);
    for (int row = F.gw; row < nrows; row += F.NGW) {
        const int bidx = row < NLAT ? (row >> 12) : NB;
        f32x4 v[4]; const u32x4 tkc = tkn;
#pragma unroll
        for (int j = 0; j < 4; ++j) { if (SRC == 1) v[j] = vn[j]; else v[j] = (f32x4){__builtin_bit_cast(float, vnb[j].x << 16), __builtin_bit_cast(float, vnb[j].x & 0xffff0000u), __builtin_bit_cast(float, vnb[j].y << 16), __builtin_bit_cast(float, vnb[j].y & 0xffff0000u)}; }
        u32x2 ya[4], yb[4]; float w0 = 0.f, w1 = 0.f;
        if (COMB) { if (row < comb_rows) { const int* tk = TOK + (size_t)row * 8; w0 = __int_as_float(tk[2]); w1 = __int_as_float(tk[3]); const int s0 = (int)tkc[2], s1 = (int)tkc[3];
#pragma unroll
            for (int j = 0; j < 4; ++j) { ya[j] = *(const GAS u32x2*)(Y + (size_t)s0 * DM + 4 * F.lane + 256 * j); yb[j] = *(const GAS u32x2*)(Y + (size_t)s1 * DM + 4 * F.lane + 256 * j); } } }
        { const int nrow = row + F.NGW; if (nrow < nrows) LOADROW(nrow, vn, vnb, tkn); }
        if (SLABS) { if (slabS > 1) { const int pm_ = row >> 8; bool any_ = false;
#pragma unroll
            for (int j = 0; j < 4; ++j) { const int tu_ = tailmap[pm_ * 4 + j]; if (tu_) { any_ = true; for (int s_ = 0; s_ < slabS; ++s_) v[j] = v[j] + *(const GAS f32x4*)(SLAB + ((size_t)(s_ * slabT + tu_ - 1) * 256 + (row & 255)) * 256 + 4 * F.lane); } }
            if (any_) {
#pragma unroll
                for (int j = 0; j < 4; ++j) XSTORE(row, j, v[j]); } } }
        if (SRC == 1) {
#pragma unroll
            for (int j = 0; j < 4; ++j) XSTORE(row, j, v[j]); }
        if (COMB) { if (row < comb_rows) { const int s0 = (int)tkc[2], s1 = (int)tkc[3];
#pragma unroll
            for (int j = 0; j < 4; ++j) { const u32x2 a = ya[j], b = yb[j];
                const f32x4 g5 = *(const GAS f32x4*)(mod_comb + (size_t)bidx * 6144 + 4 * F.lane + 256 * j);
                f32x4 ya4 = {bf2f(a.x & 0xffff), bf2f(a.x >> 16), bf2f(a.y & 0xffff), bf2f(a.y >> 16)}, yb4 = {bf2f(b.x & 0xffff), bf2f(b.x >> 16), bf2f(b.y & 0xffff), bf2f(b.y >> 16)};
                if (mS > 1) { const int ta = tailmap[(s0 >> 8) * 4 + j], tb = tailmap[(s1 >> 8) * 4 + j];
                    if (ta) { ya4 = (f32x4){0.f, 0.f, 0.f, 0.f}; for (int s_ = 0; s_ < mS; ++s_) ya4 = ya4 + *(const GAS f32x4*)(SLAB2 + ((size_t)(s_ * mT + ta - 1) * 256 + (s0 & 255)) * 256 + 4 * F.lane); }
                    if (tb) { yb4 = (f32x4){0.f, 0.f, 0.f, 0.f}; for (int s_ = 0; s_ < mS; ++s_) yb4 = yb4 + *(const GAS f32x4*)(SLAB2 + ((size_t)(s_ * mT + tb - 1) * 256 + (s1 & 255)) * 256 + 4 * F.lane); } }
                f32x4 y = ya4 * w0 + yb4 * w1;
                v[j] = v[j] + g5 * y; if (OUT != 2) XSTORE(row, j, v[j]); } } }
        if (OUT == 2 && row >= NLAT) continue;
        float s = 0.f;
#pragma unroll
        for (int j = 0; j < 4; ++j) s += (v[j][0] * v[j][0] + v[j][1] * v[j][1]) + (v[j][2] * v[j][2] + v[j][3] * v[j][3]);
        const float rstd = rsqrtf(wave_sum_dpp(s) * (1.0f / DM) + EPS);
        if (OUT == 2) {
#pragma unroll
            for (int j = 0; j < 4; ++j) __builtin_nontemporal_store(v[j] * rstd * gv[j], (GAS f32x4*)(P.out + (size_t)row * DM + 4 * F.lane + 256 * j));
            continue; }
        f32x4 hh[4];
#pragma unroll
        for (int j = 0; j < 4; ++j) { const f32x4 sh = *(const GAS f32x4*)(mod_shift + (size_t)bidx * 6144 + 4 * F.lane + 256 * j), sc = *(const GAS f32x4*)(mod_shift + (size_t)bidx * 6144 + 1024 + 4 * F.lane + 256 * j);
            hh[j] = (v[j] * rstd * gv[j]) * (sc + 1.0f) + sh; }
#pragma unroll
        for (int j = 0; j < 4; ++j) { u32x2 w; w.x = pk2(hh[j][0], hh[j][1]); w.y = pk2(hh[j][2], hh[j][3]);
            if (OUT == 0) *(GAS u32x2*)(H + (size_t)row * DM + 4 * F.lane + 256 * j) = w;
            else { const int grp = (F.lane >> 2) + 16 * j; *(GAS u32x2*)(H + ((size_t)grp * MT + row) * 16 + 4 * (F.lane & 3)) = w; } }
        if (ROUTER) { if (row < route_rows) {
            float pl[8];
#pragma unroll
            for (int e = 0; e < 8; ++e) pl[e] = 0.f;
#pragma unroll
            for (int j = 0; j < 4; ++j)
#pragma unroll
                for (int q = 0; q < 4; ++q) { const float hv = hh[j][q];
#pragma unroll
                    for (int e = 0; e < 8; ++e) pl[e] += hv * wr[j * 4 + q][e]; }
            float lg[8];
            { const bool b2 = (F.lane & 4) != 0, b1 = (F.lane & 2) != 0, b0 = (F.lane & 1) != 0; float q4[4], r2[2];
#pragma unroll
              for (int i = 0; i < 4; ++i) { const float keep = b2 ? pl[4 + i] : pl[i], send = b2 ? pl[i] : pl[4 + i]; q4[i] = keep + __shfl_xor(send, 4); }
#pragma unroll
              for (int i = 0; i < 2; ++i) { const float keep = b1 ? q4[2 + i] : q4[i], send = b1 ? q4[i] : q4[2 + i]; r2[i] = keep + __shfl_xor(send, 2); }
              float tot = (b0 ? r2[1] : r2[0]) + __shfl_xor(b0 ? r2[0] : r2[1], 1);
              tot += __shfl_xor(tot, 8); tot += __shfl_xor(tot, 16); tot += __shfl_xor(tot, 32);
#pragma unroll
              for (int e = 0; e < 8; ++e) lg[e] = __builtin_bit_cast(float, __builtin_amdgcn_readlane(__builtin_bit_cast(int, tot), e)) + b_router[e]; }
            int e0 = 0; float v0 = lg[0];
#pragma unroll
            for (int e = 1; e < 8; ++e) if (lg[e] > v0) { v0 = lg[e]; e0 = e; }
            int e1 = -1; float v1 = -3.0e38f;
#pragma unroll
            for (int e = 0; e < 8; ++e) if (e != e0 && lg[e] > v1) { v1 = lg[e]; e1 = e; }
            const float ex = __expf(v1 - v0); const float w0 = __builtin_amdgcn_rcpf(1.0f + ex), w1 = ex * w0;
            if (F.lane == 0) { const int l0 = __hip_atomic_fetch_add(hist + e0, 1, __ATOMIC_RELAXED, __HIP_MEMORY_SCOPE_WORKGROUP), l1 = __hip_atomic_fetch_add(hist + e1, 1, __ATOMIC_RELAXED, __HIP_MEMORY_SCOPE_WORKGROUP);
                int* tk = TOK + (size_t)row * 8; tk[0] = e0; tk[1] = e1; tk[2] = __float_as_int(w0); tk[3] = __float_as_int(w1); tk[4] = l0; tk[5] = l1; } } }
    }
#undef LOADROW
#undef XSTORE
    if (ROUTER) { __syncthreads(); if (F.tid < 8) ((int*)(F.ws + WS_BLKCNT))[F.blk * 8 + F.tid] = hist[F.tid]; __syncthreads(); }
}

__device__ __forceinline__ void phase_scatter(const Frame& F0, int nrows) {
    const Frame F = refresh(F0);
    const int* BC = (const int*)(F.ws + WS_BLKCNT); int* TOK = (int*)(F.ws + WS_TOK); int* TILEE = (int*)(F.ws + WS_TILEE);
    LAS int* sh = (LAS int*)(F.lds);
    for (int i = F.tid; i < F.G * 8; i += 512) sh[64 + i] = BC[i];
    __syncthreads();
    if (F.tid < 8) { sh[32 + F.tid] = 0; sh[F.tid] = 0; }
    __syncthreads();
    for (int i = F.tid; i < F.G * 8; i += 512) { const int c = sh[64 + i], e = i & 7, b = i >> 3; if (c) { __hip_atomic_fetch_add(sh + 32 + e, c, __ATOMIC_RELAXED, __HIP_MEMORY_SCOPE_WORKGROUP); if (b < F.blk) __hip_atomic_fetch_add(sh + e, c, __ATOMIC_RELAXED, __HIP_MEMORY_SCOPE_WORKGROUP); } }
    __syncthreads();
    if (F.tid == 0) { int off = 0; for (int e = 0; e < 8; ++e) { sh[8 + e] = off; off += ((sh[32 + e] + 255) >> 8) << 8; } sh[16] = off; }
    __syncthreads();
    if (F.blk == 0) { const int ntm = sh[16] >> 8; for (int t = F.tid; t < 511; t += 512) { int e = 7; for (int q = 0; q < 8; ++q) if (t * 256 >= sh[8 + q] && t * 256 < sh[9 + q]) e = q; TILEE[t] = e; } if (F.tid == 0) TILEE[511] = ntm; }
    int* S2R = (int*)(F.ws + WS_S2R);
    if (F.blk == 1 % F.G) { for (int e = 0; e < 8; ++e) { const int lo = sh[8 + e] + sh[32 + e], hi = sh[9 + e]; for (int s = lo + F.tid; s < hi; s += 512) S2R[s] = 0; } }
    { const int row = F.gw + F.lane * F.NGW;
      if (F.lane * F.NGW + F.gw < nrows) { int* tk = TOK + (size_t)row * 8; const u32x4 t0 = *(const u32x4*)tk, t1 = *(const GAS u32x4*)(tk + 4); const int e0 = (int)t0[0], e1 = (int)t0[1];
          const int s0 = sh[8 + e0] + sh[e0] + (int)t1[0], s1 = sh[8 + e1] + sh[e1] + (int)t1[1]; tk[6] = s0; tk[7] = s1; S2R[s0] = row; S2R[s1] = row; } }
    __syncthreads();
}

__device__ __forceinline__ void phase_pool(const Frame& F0) {
    const Frame F = refresh(F0);
    const bf16_t* H = (const bf16_t*)(F.ws + WS_H); bf16_t* PIN = (bf16_t*)(F.ws + WS_BIG);
    LAS unsigned char* tile = F.lds;
    u32x4 nx[12];
#define POOL_GEOM(tl_, r0_, base_, L_, t0_) const int r0_ = (tl_) * 32; int base_, L_; if (r0_ < NLAT) { base_ = r0_ & ~(SEQ - 1); L_ = SEQ; } else { base_ = NLAT + ((r0_ - NLAT) & ~(CTX - 1)); L_ = CTX; } const int t0_ = r0_ - base_
#define POOL_LOAD(tl_) do { POOL_GEOM(tl_, r0n, basen, Ln, t0n); _Pragma("unroll") for (int k = 0; k < 12; ++k) { const int i = F.tid + 512 * k, lr = i >> 7, c = i & 127, t = t0n - 8 + lr; \
            if (t >= 0 && t < Ln) nx[k] = *(const GAS u32x4*)(H + (size_t)(basen + t) * DM + c * 8); } } while (0)
    if (F.blk < MT / 32) POOL_LOAD(F.blk);
    for (int tl = F.blk; tl < MT / 32; tl += F.G) {
        POOL_GEOM(tl, r0, base, L, t0);
        __syncthreads();
#pragma unroll
        for (int k = 0; k < 12; ++k) { const int i = F.tid + 512 * k, lr = i >> 7, c = i & 127, t = t0 - 8 + lr; if (t >= 0 && t < L) *(LAS u32x4*)(tile + lr * 2048 + c * 16) = nx[k]; }
        __syncthreads();
        if (tl + F.G < MT / 32) POOL_LOAD(tl + F.G);
        { const int c8 = F.tid & 127, rq = F.tid >> 7, w = 2 << (c8 >> 5), hw = w >> 1;
#pragma unroll 2
          for (int rr = 0; rr < 8; ++rr) { const int lr = rq * 8 + rr, t = t0 + lr;
              int lo = t - hw; if (lo < 0) lo = 0; int hi = t + w - hw; if (hi > L) hi = L;
              float s[8];
#pragma unroll
              for (int q = 0; q < 8; ++q) s[q] = 0.f;
              for (int r = lo; r < hi; ++r) { const u32x4 a = *(const LAS u32x4*)(tile + (r - t0 + 8) * 2048 + c8 * 16);
                  s[0] += bf2f(a.x & 0xffff); s[1] += bf2f(a.x >> 16); s[2] += bf2f(a.y & 0xffff); s[3] += bf2f(a.y >> 16); s[4] += bf2f(a.z & 0xffff); s[5] += bf2f(a.z >> 16); s[6] += bf2f(a.w & 0xffff); s[7] += bf2f(a.w >> 16); }
              const float inv = __builtin_amdgcn_rcpf((float)(hi - lo));
              const u32x4 a = *(const LAS u32x4*)(tile + (lr + 8) * 2048 + c8 * 16);
              u32x4 o; o.x = pk2(s[0] * inv - bf2f(a.x & 0xffff), s[1] * inv - bf2f(a.x >> 16)); o.y = pk2(s[2] * inv - bf2f(a.y & 0xffff), s[3] * inv - bf2f(a.y >> 16));
              o.z = pk2(s[4] * inv - bf2f(a.z & 0xffff), s[5] * inv - bf2f(a.z >> 16)); o.w = pk2(s[6] * inv - bf2f(a.w & 0xffff), s[7] * inv - bf2f(a.w >> 16));
              *(GAS u32x4*)(PIN + (size_t)(r0 + lr) * DM + c8 * 8) = o; } }
    }
#undef POOL_GEOM
#undef POOL_LOAD
    __syncthreads();
}

__device__ __forceinline__ void phase_krope(const Frame& F0, int nrows) {
    const Frame F = refresh(F0);
    const bf16_t* Z = (const bf16_t*)(F.ws + WS_BIG + B_Z); bf16_t* KR = (bf16_t*)(F.ws + WS_BIG + B_KR); const f32x2* RT = (const f32x2*)(F.ws + WS_ROPE);
    for (int it = F.blk * 512 + F.tid; it < nrows * 4; it += F.G * 512) { const int row = it >> 2, part = it & 3;
        const u32x4 a = *(const GAS u32x4*)(Z + (size_t)row * ZW + 640 + part * 8);
        float v[8] = {bf2f(a.x & 0xffff), bf2f(a.x >> 16), bf2f(a.y & 0xffff), bf2f(a.y >> 16), bf2f(a.z & 0xffff), bf2f(a.z >> 16), bf2f(a.w & 0xffff), bf2f(a.w >> 16)};
        if (row < NLAT) { const f32x4* cs = (const f32x4*)(RT + (size_t)(row & (SEQ - 1)) * 16 + part * 4); const f32x4 c01 = cs[0], c23 = cs[1]; float x1, x2;
            x1 = v[0]; x2 = v[1]; v[0] = x1 * c01[0] - x2 * c01[1]; v[1] = x2 * c01[0] + x1 * c01[1];
            x1 = v[2]; x2 = v[3]; v[2] = x1 * c01[2] - x2 * c01[3]; v[3] = x2 * c01[2] + x1 * c01[3];
            x1 = v[4]; x2 = v[5]; v[4] = x1 * c23[0] - x2 * c23[1]; v[5] = x2 * c23[0] + x1 * c23[1];
            x1 = v[6]; x2 = v[7]; v[6] = x1 * c23[2] - x2 * c23[3]; v[7] = x2 * c23[2] + x1 * c23[3]; }
        u32x4 w; w.x = pk2(v[0], v[1]); w.y = pk2(v[2], v[3]); w.z = pk2(v[4], v[5]); w.w = pk2(v[6], v[7]);
        *(GAS u32x4*)(KR + (size_t)row * 32 + part * 8) = w;
    }
}

struct TJob { const float* W; int K, N; bf16_t* WT; int NR, map; const float* ks; };
__device__ __forceinline__ int rope_orig(int d) { return (d & 16) + ((d & 1) << 3) + ((d & 15) >> 1); }
__device__ __forceinline__ int tjob_srccol(const TJob& J, int n) {
    switch (J.map) {
        case 1: { const int pn = n >> 8, r = n & 255; return r < 128 ? 128 * pn + r : (J.N >> 1) + 128 * pn + (r - 128); }
        case 2: return n < 256 ? n : (n < 288 ? 256 + rope_orig(n - 256) : -1);
        case 3: { const int h = n / QKD, d = n % QKD; return d < 64 ? n : h * QKD + 64 + rope_orig(d - 64); }
        default: return n;
    }
}
constexpr int N_TJOBS = 51;
__device__ __forceinline__ TJob get_tjob(int j, const Params& P, unsigned char* ws) {
    TJob J; J.ks = nullptr; J.map = 0; unsigned char* wb = ws + WS_W;
    if (j < 8) { const int l = j >> 2, kind = j & 3; unsigned char* m = wb + WO_MLA + (size_t)l * W_MLA_SZ;
        if (kind == 0) { J.W = P.in[I_WDQ] + (size_t)l * DM * QLORA; J.K = DM; J.N = QLORA; J.WT = (bf16_t*)(m + W_DQKV); J.NR = QLORA; }
        else if (kind == 1) { J.W = P.in[I_WDKV] + (size_t)l * DM * 288; J.K = DM; J.N = 288; J.WT = (bf16_t*)(m + W_DQKV) + (size_t)QLORA * DM; J.NR = 384; J.map = 2; }
        else if (kind == 2) { J.W = P.in[I_WUQ] + (size_t)l * QLORA * 1536; J.K = QLORA; J.N = 1536; J.WT = (bf16_t*)(m + W_UQ); J.NR = 1536; J.map = 3; J.ks = P.in[I_QNORM] + l * QLORA; }
        else { J.W = P.in[I_WUKV] + (size_t)l * KVLORA * 2048; J.K = KVLORA; J.N = 2048; J.WT = (bf16_t*)(m + W_UKV); J.NR = 2048; J.ks = P.in[I_KVNORM] + l * KVLORA; }
    } else if (j < 10) { const int l = j - 8; J.W = P.in[I_WO] + (size_t)l * DM * DM; J.K = DM; J.N = DM; J.WT = (bf16_t*)(wb + WO_MLA + (size_t)l * W_MLA_SZ + W_O); J.NR = DM; }
    else if (j < 14) { const int k = (j - 10) >> 1, dn = (j - 10) & 1; unsigned char* m = wb + WO_FFN + (size_t)k * W_FFN_SZ;
        if (!dn) { J.W = P.in[I_FGU] + (size_t)k * DM * 2 * FFN; J.K = DM; J.N = 2 * FFN; J.WT = (bf16_t*)m; J.NR = 2 * FFN; J.map = 1; }
        else { J.W = P.in[I_FDN] + (size_t)k * FFN * DM; J.K = FFN; J.N = DM; J.WT = (bf16_t*)(m + W_GU_SZ); J.NR = DM; } }
    else if (j < 46) { const int ke = (j - 14) >> 1, dn = (j - 14) & 1; unsigned char* m = wb + WO_MOE + (size_t)ke * W_FFN_SZ;
        if (!dn) { J.W = P.in[I_MGU] + (size_t)ke * DM * 2 * FFN; J.K = DM; J.N = 2 * FFN; J.WT = (bf16_t*)m; J.NR = 2 * FFN; J.map = 1; }
        else { J.W = P.in[I_MDN] + (size_t)ke * FFN * DM; J.K = FFN; J.N = DM; J.WT = (bf16_t*)(m + W_GU_SZ); J.NR = DM; } }
    else if (j == 46) { J.W = P.in[I_S5GLU]; J.K = DM; J.N = 2048; J.WT = (bf16_t*)(wb + WO_GLU); J.NR = 2048; J.map = 1; }
    else { const int g = j - 47; J.W = P.in[I_POOLW] + (size_t)g * 65536; J.K = 256; J.N = 256; J.WT = (bf16_t*)(wb + WO_POOL + (size_t)g * 131072); J.NR = 256; }
    return J;
}
__device__ __forceinline__ void transpose_item(const TJob& J, LAS float* scr, int item, int lane) {
    const int nblk = J.NR / 32, kb = item / nblk, nb = item % nblk, k0 = 64 * kb, n0 = 32 * nb;
    const int sc = tjob_srccol(J, n0 + (lane & 31));
#pragma unroll 8
    for (int i = 0; i < 32; ++i) { const int kk = 2 * i + (lane >> 5); float v = sc >= 0 ? J.W[(size_t)(k0 + kk) * J.N + sc] : 0.f; if (J.ks) v *= J.ks[k0 + kk]; scr[kk * 33 + (lane & 31)] = v; }
    asm volatile("s_waitcnt lgkmcnt(0)" ::: "memory");
    const int c = lane & 7;
#pragma unroll
    for (int jj = 0; jj < 4; ++jj) { const int n = (lane >> 3) + 8 * jj; const LAS float* s = scr + (8 * c) * 33 + n;
        u32x4 o; o.x = pk2(s[0 * 33], s[1 * 33]); o.y = pk2(s[2 * 33], s[3 * 33]); o.z = pk2(s[4 * 33], s[5 * 33]); o.w = pk2(s[6 * 33], s[7 * 33]);
        *(GAS u32x4*)(J.WT + (size_t)(n0 + n) * J.K + k0 + 8 * c) = o; }
    asm volatile("s_waitcnt lgkmcnt(0)" ::: "memory");
}
struct TLoad { f32x4 v[16]; };
__device__ __forceinline__ void tfast_load(const TJob& J, int item, int lane, TLoad& L) {
    const int nblk = J.NR / 64, kb = item / nblk, nb = item % nblk, k0 = 64 * kb, n0 = 64 * nb;
    const int sc = tjob_srccol(J, n0) + 4 * (lane & 15);
    const float* src = J.W + (size_t)(k0 + (lane >> 4)) * J.N + sc;
#pragma unroll
    for (int i = 0; i < 16; ++i) L.v[i] = __builtin_nontemporal_load((const GAS f32x4*)(src + (size_t)(4 * i) * J.N));
}
__device__ __forceinline__ void tfast_store(const TJob& J, int item, int lane, const TLoad& L, LAS unsigned char* tile) {
    const int nblk = J.NR / 64, kb = item / nblk, nb = item % nblk, k0 = 64 * kb, n0 = 64 * nb;
#pragma unroll
    for (int i = 0; i < 16; ++i) { const int kr = 4 * i + (lane >> 4); f32x4 v = L.v[i]; if (J.ks) v = v * J.ks[k0 + kr];
        u32x2 w; w.x = cvt_pk_bf16(v[0], v[1]); w.y = cvt_pk_bf16(v[2], v[3]); *(LAS u32x2*)(tile + kr * 192 + 8 * (lane & 15)) = w; }
    asm volatile("s_waitcnt lgkmcnt(0)" ::: "memory");
    const int g = lane >> 4, i16 = lane & 15, q = (lane >> 2) & 3, p = lane & 3;
#pragma unroll
    for (int nbk = 0; nbk < 4; ++nbk)
#pragma unroll
        for (int half = 0; half < 2; ++half) { const int c = 4 * half + g;
            const unsigned a0 = (unsigned)(uintptr_t)(tile + (8 * c + q) * 192 + (16 * nbk + 4 * p) * 2);
            s16x4 lo, hi; asm volatile("ds_read_b64_tr_b16 %0, %1" : "=&v"(lo) : "v"(a0) : "memory"); asm volatile("ds_read_b64_tr_b16 %0, %1 offset:768" : "=&v"(hi) : "v"(a0) : "memory");
            asm volatile("s_waitcnt lgkmcnt(0)" : "+v"(lo), "+v"(hi) :: "memory");
            const bf16x8 o = (bf16x8){lo[0], lo[1], lo[2], lo[3], hi[0], hi[1], hi[2], hi[3]};
            *(GAS bf16x8*)(J.WT + (size_t)(n0 + 16 * nbk + i16) * J.K + k0 + 8 * c) = o; }
    asm volatile("s_waitcnt lgkmcnt(0)" ::: "memory");
}
__device__ __forceinline__ void adaln_task(const Params& P, float* MOD, const LAS float* ST, int task, int lane) {
    const int cbk = task % 192, l = task / 192, kq = lane >> 3, cq = lane & 7;
    const int col = cbk * 32 + 4 * cq, k0 = kq * 128;
    const float* W = P.in[I_ADAW] + (size_t)l * DM * 6144 + col;
    f32x4 acc[9];
#pragma unroll
    for (int r = 0; r < 9; ++r) acc[r] = (f32x4){0.f, 0.f, 0.f, 0.f};
#pragma unroll 8
    for (int kk = 0; kk < 128; ++kk) { const int k = k0 + kk; const f32x4 w = *(const GAS f32x4*)(W + (size_t)k * 6144);
#pragma unroll
        for (int r = 0; r < 9; ++r) acc[r] = acc[r] + w * ST[r * 1024 + k]; }
    const f32x4 b = *(const GAS f32x4*)(P.in[I_ADAB] + (size_t)l * 6144 + col);
#pragma unroll
    for (int r = 0; r < 9; ++r) { f32x4 v = acc[r];
#pragma unroll
        for (int q = 0; q < 4; ++q) { float x = v[q]; x += __shfl_xor(x, 8); x += __shfl_xor(x, 16); x += __shfl_xor(x, 32); v[q] = x; }
        if (kq == 0) *(GAS f32x4*)(MOD + ((size_t)l * 9 + r) * 6144 + col) = v + b; }
}
__device__ __forceinline__ void s5_precompute(const Frame& F, const Params& P, int g) {
    LAS float* LP = (LAS float*)F.lds;
    LAS float* BB = LP + 2 * 9 * 64 * 2;
    LAS float* CC = BB + 2 * 64 * 16 * 2;
    LAS float* KT = CC + 2 * 16 * 64 * 2;
    __syncthreads();
    if (F.tid < 128) { const int dir = F.tid >> 6, p = F.tid & 63; const int ix = (dir * 64 + g) * 64 + p;
        const float are = fminf(P.in[I_S5ARE][ix], -1e-4f), aim = P.in[I_S5AIM][ix], dt = expf(P.in[I_S5LDT][dir * 64 + g]);
        const float lr = are * dt, li = aim * dt, mag = expf(lr), br = mag * cosf(li), bi = mag * sinf(li);
        float pr = 1.f, pi = 0.f;
        for (int k = 0; k <= 8; ++k) { LP[((dir * 9 + k) * 64 + p) * 2] = pr; LP[((dir * 9 + k) * 64 + p) * 2 + 1] = pi; const float nr = pr * br - pi * bi, ni = pr * bi + pi * br; pr = nr; pi = ni; }
        const float xr = br - 1.f, xi = bi, den = are * are + aim * aim; const float cr = (xr * are + xi * aim) / den, ci = (xi * are - xr * aim) / den;
        for (int n = 0; n < 16; ++n) { const float b_r = P.in[I_S5BRE][(size_t)ix * 16 + n], b_i = P.in[I_S5BIM][(size_t)ix * 16 + n];
            BB[((dir * 64 + p) * 16 + n) * 2] = cr * b_r - ci * b_i; BB[((dir * 64 + p) * 16 + n) * 2 + 1] = cr * b_i + ci * b_r; }
        for (int n = 0; n < 16; ++n) { const size_t cx = ((size_t)(dir * 64 + g) * 16 + n) * 64 + p; CC[((dir * 16 + n) * 64 + p) * 2] = P.in[I_S5CRE][cx]; CC[((dir * 16 + n) * 64 + p) * 2 + 1] = P.in[I_S5CIM][cx]; }
        float* L8 = (float*)(F.ws + WS_S5L8) + ((size_t)(g * 2 + dir) * 64 + p) * 2; L8[0] = LP[((dir * 9 + 8) * 64 + p) * 2]; L8[1] = LP[((dir * 9 + 8) * 64 + p) * 2 + 1]; }
    __syncthreads();
    for (int i = F.tid; i < 2 * 8 * 256; i += 512) { const int dir = i >> 11, tau = (i >> 8) & 7, n = (i >> 4) & 15, m = i & 15; float s = 0.f;
        for (int p = 0; p < 64; ++p) { const float c_r = CC[((dir * 16 + n) * 64 + p) * 2], c_i = CC[((dir * 16 + n) * 64 + p) * 2 + 1], l_r = LP[((dir * 9 + tau) * 64 + p) * 2], l_i = LP[((dir * 9 + tau) * 64 + p) * 2 + 1];
            const float w_r = c_r * l_r - c_i * l_i, w_i = c_r * l_i + c_i * l_r; const float b_r = BB[((dir * 64 + p) * 16 + m) * 2], b_i = BB[((dir * 64 + p) * 16 + m) * 2 + 1];
            s += w_r * b_r - w_i * b_i; }
        KT[i] = s; }
    __syncthreads();
    bf16_t* FBg = (bf16_t*)(F.ws + WS_S5FB) + (size_t)g * 2 * 32 * 512; bf16_t* EBg = (bf16_t*)(F.ws + WS_S5EB) + (size_t)g * 2 * 32 * 512; bf16_t* MBg = (bf16_t*)(F.ws + WS_S5MB) + (size_t)g * 32 * 512;
    const float* Dv = P.in[I_S5D] + g * 16;
    for (int i = F.tid; i < 2 * 32 * 512; i += 512) { const int j = i & 7, lane = (i >> 3) & 63, frag = (i >> 9) & 31, dir = i >> 14; const int h = lane >> 5, col = lane & 31;
        {
            const int s = frag >> 2, jn = frag & 3, p = (jn >> 1) * 32 + col, c = jn & 1, m = 8 * h + j, pw = dir == 0 ? 7 - s : s;
            const float l_r = LP[((dir * 9 + pw) * 64 + p) * 2], l_i = LP[((dir * 9 + pw) * 64 + p) * 2 + 1], b_r = BB[((dir * 64 + p) * 16 + m) * 2], b_i = BB[((dir * 64 + p) * 16 + m) * 2 + 1];
            FBg[i] = (bf16_t)f2bf(c == 0 ? l_r * b_r - l_i * b_i : l_r * b_i + l_i * b_r); }
        {
            const int ks = frag >> 2, jn = frag & 3, t = 2 * jn + (col >> 4), n = col & 15, k = 16 * ks + 8 * h + j, p = k >> 1, c = k & 1, pw = dir == 0 ? t + 1 : 8 - t;
            const float c_r = CC[((dir * 16 + n) * 64 + p) * 2], c_i = CC[((dir * 16 + n) * 64 + p) * 2 + 1], l_r = LP[((dir * 9 + pw) * 64 + p) * 2], l_i = LP[((dir * 9 + pw) * 64 + p) * 2 + 1];
            EBg[i] = (bf16_t)f2bf(c == 0 ? c_r * l_r - c_i * l_i : -(c_r * l_i + c_i * l_r)); } }
    for (int i = F.tid; i < 32 * 512; i += 512) { const int j = i & 7, lane = (i >> 3) & 63, frag = i >> 9; const int h = lane >> 5, col = lane & 31;
        const int s = frag >> 2, jn = frag & 3, t = 2 * jn + (col >> 4), n = col & 15, m = 8 * h + j; float v = 0.f;
        if (t >= s) v += KT[((0 * 8 + (t - s)) * 16 + n) * 16 + m];
        if (s >= t) v += KT[((1 * 8 + (s - t)) * 16 + n) * 16 + m];
        if (t == s && n == m) v += Dv[n];
        MBg[i] = (bf16_t)f2bf(v); }
    __syncthreads();
}
constexpr int BG_GLU = 512, BG_PER_E = 2112, BG_K0_END = BG_GLU + 8 * BG_PER_E, BG_TOTAL = BG_GLU + 16 * BG_PER_E;
constexpr int BG_R12_LO = BG_GLU, BG_R12_HI = BG_GLU + 2000;
constexpr int BG_R16_LO = BG_K0_END, BG_R16_HI = BG_K0_END + 6000;
constexpr int BG_S5A_LO = BG_R16_HI, BG_S5A_HI = BG_R16_HI + 7000;
__device__ __forceinline__ void bg_items(const Params& P, unsigned char* ws, int lo, int hi, int sw, int NSW, int lane, LAS unsigned char* tile) {
    TLoad La, Lb;
#define BG_JOB(g_, J_, it_) do { int j_, r_; if ((g_) < BG_GLU) { j_ = 46; r_ = (g_); } else { const int q_ = (g_) - BG_GLU, ke_ = q_ / BG_PER_E, rr_ = q_ % BG_PER_E; if (rr_ < 1408) { j_ = 14 + 2 * ke_; r_ = rr_; } else { j_ = 15 + 2 * ke_; r_ = rr_ - 1408; } } \
        J_ = get_tjob(j_, P, ws); it_ = r_; } while (0)
    int g = lo + sw; TJob Ja, Jb; int ia = 0, ib = 0;
    if (g < hi) { BG_JOB(g, Ja, ia); tfast_load(Ja, ia, lane, La); }
    for (; g < hi; g += 2 * NSW) {
        const int g1 = g + NSW, g2 = g + 2 * NSW;
        if (g1 < hi) { BG_JOB(g1, Jb, ib); tfast_load(Jb, ib, lane, Lb); }
        tfast_store(Ja, ia, lane, La, tile);
        if (g1 < hi) { const TJob Jc = Jb; const int ic = ib; if (g2 < hi) { BG_JOB(g2, Ja, ia); tfast_load(Ja, ia, lane, La); } tfast_store(Jc, ic, lane, Lb, tile); }
    }
#undef BG_JOB
}
__device__ __forceinline__ void bg_convert(const Frame& F0, const Params& P, int lo, int hi, int c, int short_c0) {
    if (c < short_c0 || lo >= hi) return;
    const Frame F = refresh(F0);
    __syncthreads();
    bg_items(P, F.ws, lo, hi, (c - short_c0) * 8 + F.wave, (F.G - short_c0) * 8, F.lane, F.lds + F.wave * 12288);
    __syncthreads();
}
__device__ __forceinline__ void phase_p0(const Frame& F0, const Params& P) {
    const Frame F = refresh(F0);
    const bool bg = (F.G == 256);
    for (int g = F.blk; g < 64; g += F.G) s5_precompute(F, P, g);
    { f32x2* RT = (f32x2*)(F.ws + WS_ROPE);
      for (int i = F.blk * 512 + F.tid; i < SEQ * 16; i += F.G * 512) { const int t = i >> 4, a = (i >> 3) & 1, f = i & 7; const float pos = (float)(a == 0 ? (t >> 6) : (t & 63));
          const float inv = 1.0f / powf(10000.0f, (float)f / 8.0f); const float ang = pos * inv; RT[i] = (f32x2){cosf(ang), sinf(ang)}; } }
    float* MOD = (float*)(F.ws + CTL_MOD);
    int base = 0;
    { LAS float* ST = (LAS float*)(F.lds + 98304);
      for (int i = F.tid; i < 9 * 1024; i += 512) { const float cv = i < 8192 ? P.in[I_C][i] : P.in[I_CCTX][i - 8192]; ST[i] = siluf_(cv); }
      __syncthreads();
      if ((F.gw & 1) == 0) { for (int it = F.gw >> 1; it < 4 * 192; it += (F.NGW + 1) >> 1) adaln_task(P, MOD, ST, it, F.lane); } }
    LAS float* scr = (LAS float*)(F.lds + F.wave * 12288);
    LAS unsigned char* tile = F.lds + F.wave * 12288;
    for (int j = 0; j < N_TJOBS; ++j) { if (bg && j >= 14 && j <= 46) continue;
        const TJob J = get_tjob(j, P, F.ws);
        const bool fast = (J.map == 0 || J.map == 1) && (J.NR % 64 == 0);
        const int n = fast ? (J.K / 64) * (J.NR / 64) : (J.K / 64) * (J.NR / 32);
        int first = (F.gw - base) % F.NGW; if (first < 0) first += F.NGW;
        if (fast) { TLoad La, Lb;
            if (first < n) tfast_load(J, first, F.lane, La);
            for (int it = first; it < n; it += 2 * F.NGW) {
                if (it + F.NGW < n) tfast_load(J, it + F.NGW, F.lane, Lb);
                tfast_store(J, it, F.lane, La, tile);
                if (it + F.NGW < n) { if (it + 2 * F.NGW < n) tfast_load(J, it + 2 * F.NGW, F.lane, La); tfast_store(J, it + F.NGW, F.lane, Lb, tile); } } }
        else for (int it = first; it < n; it += F.NGW) transpose_item(J, scr, it, F.lane);
        base += n; }
    if (bg) { bg_convert(F, P, 0, BG_R12_LO, F.blk, 0); bg_convert(F, P, BG_R12_HI, BG_R16_LO, F.blk, 0); bg_convert(F, P, BG_S5A_HI, BG_TOTAL, F.blk, 64); }
}

__device__ __forceinline__ void s5_chunk_rows(int dir, int b, int Ppos, int& row0) {
    int cn; bool ctx;
    if (dir == 0) { ctx = Ppos < 32; cn = ctx ? Ppos : Ppos - 32; } else { ctx = Ppos < 32; cn = ctx ? 31 - Ppos : 543 - Ppos; }
    row0 = ctx ? NLAT + b * CTX + cn * 8 : b * SEQ + cn * 8;
}
__device__ __forceinline__ void s5_mfma_stage(f32x16 (&acc)[4], const bf16x8 (&a)[8], const LAS unsigned char* fb, int lane) {
    bf16x8 f[2][4];
#pragma unroll
    for (int jn = 0; jn < 4; ++jn) f[0][jn] = *(const LAS bf16x8*)(fb + (jn * 64 + lane) * 16);
#pragma unroll
    for (int s = 0; s < 8; ++s) {
        if (s < 7) {
#pragma unroll
            for (int jn = 0; jn < 4; ++jn) f[(s + 1) & 1][jn] = *(const LAS bf16x8*)(fb + (((s + 1) * 4 + jn) * 64 + lane) * 16); }
#pragma unroll
        for (int jn = 0; jn < 4; ++jn) acc[jn] = __builtin_amdgcn_mfma_f32_32x32x16_bf16(a[s], f[s & 1][jn], acc[jn], 0, 0, 0);
        asm volatile("" ::: "memory");
    }
}
__device__ __forceinline__ void phase_s5a(const Frame& F0, const Params& P, bool bg) {
    const Frame F = refresh(F0);
    const bf16_t* Hg = (const bf16_t*)(F.ws + WS_H); bf16_t* SIN = (bf16_t*)(F.ws + WS_BIG + B_SIN);
    for (int item = F.blk; item < 256; item += F.G) {
        const int gd = item >> 1, g = gd >> 1, dir = gd & 1;
        __syncthreads();
        { const u32x4* src = (const u32x4*)((const bf16_t*)(F.ws + WS_S5FB) + (size_t)gd * 32 * 512); LAS u32x4* dst = (LAS u32x4*)F.lds;
          for (int i = F.tid; i < 2048; i += 512) dst[i] = src[i]; }
        __syncthreads();
        if (F.wave < 2) {
            const int pair = (item & 1) * 2 + F.wave; const int lane = F.lane, rho = lane & 31, h = lane >> 5, ncol = rho, hi = h;
            const int bA = pair * 2 + ((rho >> 2) & 1), rA = (rho & 3) + 4 * (rho >> 3);
            const int bS = pair * 2 + hi;
            const float* L8 = (const float*)(F.ws + WS_S5L8) + (size_t)gd * 128;
            const float a0r = L8[ncol * 2], a0i = L8[ncol * 2 + 1], a1r = L8[(32 + ncol) * 2], a1i = L8[(32 + ncol) * 2 + 1];
            float s0r = 0.f, s0i = 0.f, s1r = 0.f, s1i = 0.f;
            bf16_t* sinb = SIN + ((size_t)(g * 2 + dir) * 8 + bS) * 544 * 128;
            { unsigned* z = (unsigned*)sinb; z[ncol] = 0u; z[32 + ncol] = 0u; }
            const bf16_t* hgb = Hg + (size_t)g * MT * 16 + 8 * h;
            bf16x8 ua[8], un[8];
            { int row0; s5_chunk_rows(dir, bA, rA, row0);
#pragma unroll
              for (int s = 0; s < 8; ++s) ua[s] = *(const GAS bf16x8*)(hgb + (size_t)(row0 + s) * 16); }
            for (int tile = 0; tile < 34; ++tile) {
                { int row0; s5_chunk_rows(dir, bA, (tile < 33 ? tile + 1 : tile) * 16 + rA, row0);
#pragma unroll
                  for (int s = 0; s < 8; ++s) un[s] = *(const GAS bf16x8*)(hgb + (size_t)(row0 + s) * 16); }
                f32x16 acc[4];
#pragma unroll
                for (int jn = 0; jn < 4; ++jn) acc[jn] = f32x16{};
                s5_mfma_stage(acc, ua, F.lds, lane);
                unsigned* dbase = (unsigned*)(sinb + (size_t)(tile * 16 + 1) * 128) + ncol;
#pragma unroll
                for (int r = 0; r < 16; ++r) {
                    float nr = a0r * s0r - a0i * s0i + acc[0][r], ni = a0r * s0i + a0i * s0r + acc[1][r]; s0r = nr; s0i = ni;
                    nr = a1r * s1r - a1i * s1i + acc[2][r]; ni = a1r * s1i + a1i * s1r + acc[3][r]; s1r = nr; s1i = ni;
                    if (r < 15 || tile < 33) { dbase[r * 64] = pk2(s0r, s0i); dbase[r * 64 + 32] = pk2(s1r, s1i); } }
#pragma unroll
                for (int s = 0; s < 8; ++s) ua[s] = un[s];
            }
        }
        else if (bg && item == F.blk) bg_items(P, F.ws, BG_S5A_LO, BG_S5A_HI, F.blk * 6 + (F.wave - 2), F.G * 6, F.lane, F.lds + 32768 + (F.wave - 2) * 12288);
    }
    __syncthreads();
}
__device__ __forceinline__ void phase_s5b(const Frame& F0) {
    const Frame F = refresh(F0);
    const bf16_t* Hg = (const bf16_t*)(F.ws + WS_H); const bf16_t* SIN = (const bf16_t*)(F.ws + WS_BIG + B_SIN); bf16_t* Gout = (bf16_t*)(F.ws + WS_BIG + B_G);
    for (int item = F.blk; item < 256; item += F.G) {
        const int g = item >> 2, qt = item & 3;
        __syncthreads();
        { const u32x4* s1 = (const u32x4*)((const bf16_t*)(F.ws + WS_S5MB) + (size_t)g * 32 * 512); const u32x4* s2 = (const u32x4*)((const bf16_t*)(F.ws + WS_S5EB) + (size_t)g * 64 * 512); LAS u32x4* dst = (LAS u32x4*)F.lds;
          for (int i = F.tid; i < 2048; i += 512) dst[i] = s1[i];
          for (int i = F.tid; i < 4096; i += 512) dst[2048 + i] = s2[i]; }
        __syncthreads();
        const int lane = F.lane, rho = lane & 31, h = lane >> 5;
        for (int tile = qt * 34 + F.wave; tile < qt * 34 + 34; tile += 8) {
            const int b = tile / 17, tq = tile % 17;
            const int rowbase = tq == 0 ? NLAT + b * CTX : b * SEQ + (tq - 1) * 256;
            const int cc = tq * 32 + rho; const int Pf = cc, Pr = tq == 0 ? 31 - cc : 575 - cc;
            const bf16_t* up = Hg + ((size_t)g * MT + rowbase + rho * 8) * 16 + 8 * h;
            const bf16_t* sf = SIN + (((size_t)(g * 2 + 0) * 8 + b) * 544 + Pf) * 128 + 8 * h; const bf16_t* sr = SIN + (((size_t)(g * 2 + 1) * 8 + b) * 544 + Pr) * 128 + 8 * h;
            f32x16 acc[4];
#pragma unroll
            for (int jn = 0; jn < 4; ++jn) acc[jn] = f32x16{};
            bf16x8 a[8], af[8], ar[8];
#pragma unroll
            for (int s = 0; s < 8; ++s) { a[s] = *(const GAS bf16x8*)(up + 16 * s); af[s] = *(const GAS bf16x8*)(sf + 16 * s); ar[s] = *(const GAS bf16x8*)(sr + 16 * s); }
            s5_mfma_stage(acc, a, F.lds, lane);
            s5_mfma_stage(acc, af, F.lds + 32768, lane);
            s5_mfma_stage(acc, ar, F.lds + 65536, lane);
            const int col = lane & 31, n = col & 15, toff = col >> 4;
            bf16_t* ob = Gout + (size_t)(rowbase + 32 * h + toff) * DM + g * 16 + n;
#pragma unroll
            for (int r = 0; r < 16; ++r)
#pragma unroll
                for (int jn = 0; jn < 4; ++jn) ob[(size_t)(8 * ((r & 3) + 8 * (r >> 2)) + 2 * jn) * DM] = (bf16_t)f2bf(gelu_tanh(acc[jn][r]));
        }
    }
    __syncthreads();
}

constexpr int LDS_BYTES = 163840;
constexpr int LDSCTL_OFF = 159744;
constexpr int N_PHASES = 33;

__device__ __forceinline__ unsigned char* wmla(unsigned char* ws, int j) { return ws + WS_W + WO_MLA + (size_t)j * W_MLA_SZ; }

__device__ __forceinline__ void moe_fixup(const Frame& F0, const pg8::Sched& S, bf16_t* Y, const float* SLAB) {
    const Frame F = refresh(F0);
    const int R = S.nwg / S.G, T = S.nwg - R * S.G;
    for (int task = F.gw; task < T * 256; task += F.NGW) { const int tu = task >> 8, r = task & 255; pg8::Unit u; S.map((long)R * S.G + tu, u);
        f32x4 a = *(const GAS f32x4*)(SLAB + ((size_t)tu * 256 + r) * 256 + 4 * F.lane);
        for (int s = 1; s < S.S; ++s) a = a + *(const GAS f32x4*)(SLAB + ((size_t)(s * T + tu) * 256 + r) * 256 + 4 * F.lane);
        u32x2 w; w.x = pk2(a[0], a[1]); w.y = pk2(a[2], a[3]); *(GAS u32x2*)(Y + ((size_t)u.pm * 256 + r) * DM + u.pn * 256 + 4 * F.lane) = w; }
}

__global__ void __launch_bounds__(512, 2) fwd_kernel(Params P) {
    extern __shared__ __attribute__((aligned(16))) unsigned char lds_raw[];
    Frame F; F.lds = (LAS unsigned char*)lds_raw; F.tid = threadIdx.x; F.lane = F.tid & 63; F.wave = __builtin_amdgcn_readfirstlane(F.tid >> 6);
    F.blk = blockIdx.x; F.G = gridDim.x; F.gw = F.blk * 8 + F.wave; F.NGW = F.G * 8; F.ws = P.ws;
    unsigned char* ws = P.ws;
    const int lo = P.ph_lo, hi = P.ph_hi;
    { int t0 = threadIdx.x; asm volatile("" : "+v"(t0)); for (int u = t0; u < (LDS_BYTES - LDSCTL_OFF) / 4; u += 512) ((LAS unsigned*)(F.lds + LDSCTL_OFF))[u] = 0u; }
    __syncthreads();
    unsigned* barw = (unsigned*)(ws + CTL_BAR) + (size_t)P.li * XCD_BAR_WORDS;
    XcdBarrier bar; bar.bar = barw; bar.x = 0; bar.st = (volatile LAS unsigned*)(F.lds + LDSCTL_OFF + 64);
    if (hi - lo > 1) bar = xcd_barrier_post(barw, (volatile LAS unsigned*)(F.lds + LDSCTL_OFF + 64));
#ifndef ONLY_LO
#define ONLY_LO 0
#define ONLY_HI 99
#endif
#define IN(k) ((k) >= ONLY_LO && (k) < ONLY_HI && lo <= (k) && (k) < hi)
#define SEAM(k) do { if (IN((k) + 1)) xcd_barrier(bar); } while (0)
    float* MOD = (float*)(ws + CTL_MOD); bf16_t* X = (bf16_t*)(ws + WS_X); bf16_t* H = (bf16_t*)(ws + WS_H); unsigned char* BIG = ws + WS_BIG;
    float* SSQ = (float*)(ws + WS_SSQ); const f32x2* ROPE_T = (const f32x2*)(ws + WS_ROPE);
    const int* TILEE = (const int*)(ws + WS_TILEE);
    const int vcu = (F.G % 8 == 0) ? (F.blk % 8) * (F.G / 8) + F.blk / 8 : F.blk;
    const int c2 = (F.G % 8 == 0 && F.G >= 256) ? (F.blk + F.G / 2) % F.G : F.blk;

#ifndef T_NOKR
#define T_NOKR 0
#endif
#ifndef T_NOUQ
#define T_NOUQ 0
#endif
#ifndef T_NOKV
#define T_NOKV 0
#endif
    const bool BGMODE = (F.G == 256) && !P.pad;
    bf16_t* Xr = P.pad ? (bf16_t*)(BIG + (size_t)360 * MiB) : X;
#define MODP(l, k) (MOD + (size_t)(l) * 9 * 6144 + (k) * 1024)
#define GEMMX(EPI, e, Aptr, lda_, Bptr, K_, nM_, nN_, cc, SPLIT) do { pg8::Sched S; S.init((nM_), (nN_), F.G, (cc), (K_) / 64, (SPLIT)); S.A = (const char*)(Aptr); S.a_tile = (size_t)256 * (lda_) * 2; S.B = (const char*)(Bptr); S.b_tile = (size_t)256 * (K_) * 2; \
        pg8::gemm_phase<EPI>(F.lds, (K_), (lda_), S, e); } while (0)
#define GEMM(EPI, e, Aptr, lda_, Bptr, K_, nM_, nN_, cc) GEMMX(EPI, e, Aptr, lda_, Bptr, K_, nM_, nN_, cc, false)

    if (IN(0)) { phase_p0(F, P); SEAM(0); }

#define MLA_LAYER(PH, L, J, QROWS_TILES, CTXQ) \
    if (IN(PH)) { EpiZ e{(bf16_t*)(BIG + B_Z), SSQ}; GEMM(EpiZ, e, H, DM, wmla(ws, J) + W_DQKV, DM, MT / 256, 3, F.blk); SEAM(PH); } \
    if (IN(PH + 1)) { if (!T_NOKR) phase_krope(F, MT); \
        if (!T_NOUQ) { EpiQ e{(bf16_t*)(BIG + B_Q), SSQ, ROPE_T}; GEMM(EpiQ, e, BIG + B_Z, ZW, wmla(ws, J) + W_UQ, QLORA, QROWS_TILES, 6, F.blk); } \
        if (!T_NOKV) { EpiKV e{(bf16_t*)(BIG + B_K), (bf16_t*)(BIG + B_V), SSQ}; GEMM(EpiKV, e, BIG + B_Z + QLORA * 2, ZW, wmla(ws, J) + W_UKV, KVLORA, MT / 256, 8, c2); } \
        SEAM(PH + 1); } \
    if (IN(PH + 2)) { const bf16_t* Qb = (const bf16_t*)(BIG + B_Q); const bf16_t* Kb = (const bf16_t*)(BIG + B_K); const bf16_t* Vb = (const bf16_t*)(BIG + B_V); const bf16_t* KRb = (const bf16_t*)(BIG + B_KR); \
        for (int ui = vcu; ui < NB * NHEAD * 16; ui += F.G) { const int bh = ui >> 4, qb = ui & 15, b = bh >> 4, h = bh & 15; \
            att::attn_unit(Qb, Kb, Vb, H, KRb, b * SEQ + qb * 256, NLAT + b * CTX, b * SEQ, h, 68, F.lds); } \
        if (CTXQ) for (int ui = vcu; ui < NB * NHEAD; ui += F.G) { const int b = ui >> 4, h = ui & 15; att::attn_unit(Qb, Kb, Vb, H, KRb, NLAT + b * CTX, NLAT + b * CTX, b * SEQ, h, 4, F.lds); } \
        SEAM(PH + 2); } \
    if (IN(PH + 3)) { EpiResid e{Xr, MODP(L, 2), nullptr, (float*)(BIG + B_SLAB)}; GEMMX(EpiResid, e, H, DM, wmla(ws, J) + W_O, DM, QROWS_TILES, 4, F.blk, (L) == 0 && !P.pad); SEAM(PH + 3); }

#define FFN_LAYER(PH, L, KF) \
    if (IN(PH)) { EpiSwiGLU e{(bf16_t*)BIG}; GEMM(EpiSwiGLU, e, H, DM, ws + WS_W + WO_FFN + (size_t)(KF) * W_FFN_SZ, DM, MT / 256, 22, F.blk); SEAM(PH); } \
    if (IN(PH + 1)) { EpiResid e{Xr, MODP(L, 5), nullptr, (float*)(BIG + B_SLAB)}; GEMMX(EpiResid, e, BIG, FFN, ws + WS_W + WO_FFN + (size_t)(KF) * W_FFN_SZ + W_GU_SZ, FFN, MT / 256, 4, F.blk, !P.pad); SEAM(PH + 1); }

#define MOE_LAYER(PH, KM, NROWS) \
    if (IN(PH)) { phase_scatter(F, NROWS); SEAM(PH); } \
    if (IN(PH + 1)) { const int ntm = __builtin_amdgcn_readfirstlane(TILEE[511]); pg8::Sched S; S.init(ntm, 22, F.G, F.blk, DM / 64); S.A = (const char*)H; S.a_tile = 0; S.gather = (const int*)(ws + WS_S2R); \
        S.B = (const char*)(ws + WS_W + WO_MOE + (size_t)(KM) * 8 * W_FFN_SZ); S.b_tile = (size_t)256 * DM * 2; S.b_exp = W_FFN_SZ; S.tile_e = TILEE; \
        EpiSwiGLU e{(bf16_t*)(BIG + B_ACTM)}; pg8::gemm_phase<EpiSwiGLU, true, true>(F.lds, DM, DM, S, e); SEAM(PH + 1); } \
    if (IN(PH + 2)) { const int ntm = __builtin_amdgcn_readfirstlane(TILEE[511]); pg8::Sched S; const bool msplit = (KM) == 1 && !P.pad && (hi - lo > 1);     \
        S.init(ntm, 4, F.G, F.blk, FFN / 64, msplit, 8); S.A = (const char*)(BIG + B_ACTM); S.a_tile = (size_t)256 * FFN * 2; \
        S.B = (const char*)(ws + WS_W + WO_MOE + (size_t)(KM) * 8 * W_FFN_SZ + W_GU_SZ); S.b_tile = (size_t)256 * FFN * 2; S.b_exp = W_FFN_SZ; S.tile_e = TILEE; \
        EpiBf16 e{(bf16_t*)(BIG + B_XG), DM, (float*)(ws + WS_SLAB2)}; pg8::gemm_phase<EpiBf16>(F.lds, FFN, FFN, S, e); \
        if (BGMODE && (KM) == 0) { int sc0 = (ntm * 4) % 256; if (256 - sc0 < 128) sc0 = 0; bg_convert(F, P, BG_R16_LO, BG_R16_HI, F.blk, sc0); } \
        if (S.S > 1) { xcd_barrier(bar); moe_fixup(F, S, (bf16_t*)(BIG + B_XG), (const float*)(ws + WS_SLAB2)); }     \
        SEAM(PH + 2); }

    if (IN(1)) { phase_rows<1, false, 0, false>(F, P, MT, P.in[I_N1G] + 0 * DM, MODP(0, 0), nullptr, 0, nullptr, nullptr, 0); SEAM(1); }
    MLA_LAYER(2, 0, 0, MT / 256, true)
    if (IN(6)) { phase_rows<0, false, 0, false, true>(F, P, MT, P.in[I_N2G] + 0 * DM, MODP(0, 3), nullptr, 0, nullptr, nullptr, 0, DM / 64); SEAM(6); }
    FFN_LAYER(7, 0, 0)
    if (IN(9)) { phase_rows<0, false, 1, false, true>(F, P, MT, P.in[I_N1G] + 1 * DM, MODP(1, 0), nullptr, 0, nullptr, nullptr, 0, FFN / 64); SEAM(9); }
    if (IN(10)) { phase_s5a(F, P, BGMODE); SEAM(10); }
    if (IN(11)) { phase_s5b(F); SEAM(11); }
    if (IN(12)) { EpiGLU e{X, MODP(1, 2)}; GEMM(EpiGLU, e, BIG + B_G, DM, ws + WS_W + WO_GLU, DM, MT / 256, 8, F.blk); if (BGMODE) bg_convert(F, P, BG_R12_LO, BG_R12_HI, F.blk, 64); SEAM(12); }
    if (IN(13)) { phase_rows<0, false, 0, true>(F, P, MT, P.in[I_N2G] + 1 * DM, MODP(1, 3), nullptr, 0, P.in[I_MRW], P.in[I_MRB], MT); SEAM(13); }
    MOE_LAYER(14, 0, MT)
    if (IN(17)) { phase_rows<0, true, 0, false>(F, P, MT, P.in[I_N1G] + 2 * DM, MODP(2, 0), MODP(1, 5), MT, nullptr, nullptr, 0); SEAM(17); }
    if (IN(18)) { phase_pool(F); SEAM(18); }
    if (IN(19)) { pg8::Sched S; S.init(MT / 256, 4, F.G, F.blk, 256 / 64); S.A = (const char*)BIG; S.a_tile = (size_t)256 * DM * 2; S.a_pn = 512; S.B = (const char*)(ws + WS_W + WO_POOL); S.b_tile = (size_t)256 * 256 * 2;
        EpiResidT<true> e{X, MODP(2, 2), P.in[I_POOLS], nullptr}; pg8::gemm_phase<EpiResidT<true>>(F.lds, 256, DM, S, e); SEAM(19); }
    if (IN(20)) { phase_rows<0, false, 0, false>(F, P, MT, P.in[I_N2G] + 2 * DM, MODP(2, 3), nullptr, 0, nullptr, nullptr, 0); SEAM(20); }
    FFN_LAYER(21, 2, 1)
    if (IN(23)) { phase_rows<0, false, 0, false, true>(F, P, MT, P.in[I_N1G] + 3 * DM, MODP(3, 0), nullptr, 0, nullptr, nullptr, 0, FFN / 64); SEAM(23); }
    MLA_LAYER(24, 3, 1, NLAT / 256, false)
    if (IN(28)) { phase_rows<0, false, 0, true>(F, P, NLAT, P.in[I_N2G] + 3 * DM, MODP(3, 3), nullptr, 0, P.in[I_MRW] + DM * NEXP, P.in[I_MRB] + NEXP, NLAT); SEAM(28); }
    MOE_LAYER(29, 1, NLAT)
    if (IN(32)) { phase_rows<0, true, 2, false>(F, P, NLAT, P.in[I_FNG], nullptr, MODP(3, 5), NLAT, nullptr, nullptr, 0); }
#undef IN
#undef SEAM
}

#ifndef MK_PER_PHASE
#define MK_PER_PHASE 0
#endif
extern "C" void kernel_launch(void* const* d_in, const int* in_sizes, int n_in, void* d_out, int out_size, void* d_ws, size_t ws_size, hipStream_t stream) {
    static int grid = 0;
    if (grid == 0) {
        if (n_in != 33 || ws_size < WS_END) { fprintf(stderr, "kernel_launch: n_in %d ws %zu (need %zu)\n", n_in, ws_size, (size_t)WS_END); grid = -1; return; }
        int dev = 0, cus = 0;
        if (hipGetDevice(&dev) != hipSuccess || hipDeviceGetAttribute(&cus, hipDeviceAttributeMultiprocessorCount, dev) != hipSuccess) { grid = -1; return; }
        if (hipFuncSetAttribute((const void*)fwd_kernel, hipFuncAttributeMaxDynamicSharedMemorySize, LDS_BYTES) != hipSuccess) { grid = -1; return; }
        int per_cu = 0; (void)hipOccupancyMaxActiveBlocksPerMultiprocessor(&per_cu, (const void*)fwd_kernel, 512, LDS_BYTES); (void)hipGetLastError();
        grid = cus > 256 ? 256 : cus;
    }
    if (grid < 0) return;
#if MK_PER_PHASE || defined(PROBE_REPEAT)
    (void)hipMemsetAsync((char*)d_ws + WS_CTL, 0, CTL_ZERO_BYTES, stream);
#else
    (void)hipMemsetAsync((char*)d_ws + CTL_BAR, 0, (size_t)XCD_BAR_WORDS * 4, stream);
#endif
    Params p{};
    for (int i = 0; i < 33; ++i) p.in[i] = (const float*)d_in[i];
    p.out = (float*)d_out; p.ws = (unsigned char*)d_ws;
#if MK_PER_PHASE
    for (int k = 0; k < N_PHASES; ++k) { p.ph_lo = k; p.ph_hi = k + 1; hipLaunchKernelGGL(fwd_kernel, dim3(grid), dim3(512), LDS_BYTES, stream, p); }
#elif defined(PROBE_REPEAT)
    {
      const int rep[] = {PROBE_REPEAT}; const int nrep = sizeof(rep) / sizeof(rep[0]); int prev = 0;
      for (int i = 0; i < nrep; ++i) { p.li = i; p.ph_lo = prev; p.ph_hi = rep[i] + 1; hipLaunchKernelGGL(fwd_kernel, dim3(grid), dim3(512), LDS_BYTES, stream, p);
          p.ph_lo = rep[i]; p.ph_hi = rep[i] + 1; p.pad = 1; hipLaunchKernelGGL(fwd_kernel, dim3(grid), dim3(512), LDS_BYTES, stream, p); p.pad = 0; prev = rep[i] + 1; }
      if (prev < N_PHASES) { p.li = nrep; p.ph_lo = prev; p.ph_hi = N_PHASES; hipLaunchKernelGGL(fwd_kernel, dim3(grid), dim3(512), LDS_BYTES, stream, p); } }
#else
    p.ph_lo = 0; p.ph_hi = N_PHASES; hipLaunchKernelGGL(fwd_kernel, dim3(grid), dim3(512), LDS_BYTES, stream, p);
#endif
}
```

```cpp
#include <hip/hip_runtime.h>
#include <hip/hip_bf16.h>
#include <cstdio>
#include <cstdint>

#define LAS __attribute__((address_space(3)))
#define GAS __attribute__((address_space(1)))
typedef unsigned short bf16_t;
typedef short bf16x8 __attribute__((ext_vector_type(8)));
typedef short s16x4 __attribute__((ext_vector_type(4)));
typedef float f32x4 __attribute__((ext_vector_type(4)));
typedef float f32x2 __attribute__((ext_vector_type(2)));
typedef float f32x16 __attribute__((ext_vector_type(16)));
typedef unsigned u32x4 __attribute__((ext_vector_type(4)));
typedef unsigned u32x2 __attribute__((ext_vector_type(2)));

constexpr int DM = 1024, NB = 8, SEQ = 4096, CTX = 256;
constexpr int NLAT = NB * SEQ;
constexpr int NCTX = NB * CTX;
constexpr int MT = NLAT + NCTX;
constexpr int QLORA = 384, KVLORA = 256, ROPE = 32, NHEAD = 16, QKD = 96, VD = 64;
constexpr int ZW = 768;
constexpr int FFN = 2816, NEXP = 8;
constexpr float EPS = 1e-6f;
constexpr int NKEY = CTX + SEQ;
constexpr float ATT_C2 = 0.10206207261596577f * 1.4426950408889634f;

__device__ __forceinline__ unsigned f2bf(float f) { unsigned u = __builtin_bit_cast(unsigned, f); return (u + 0x7fffu + ((u >> 16) & 1u)) >> 16; }
__device__ __forceinline__ float bf2f(unsigned short b) { return __builtin_bit_cast(float, ((unsigned)b) << 16); }
__device__ __forceinline__ unsigned cvt_pk_bf16(float lo, float hi) { unsigned r; asm volatile("v_cvt_pk_bf16_f32 %0, %1, %2" : "=v"(r) : "v"(lo), "v"(hi)); return r; }
__device__ __forceinline__ unsigned pk2(float lo, float hi) { return cvt_pk_bf16(lo, hi); }
__device__ __forceinline__ float wave_sum(float v) {
#pragma unroll
    for (int o = 1; o < 64; o <<= 1) v += __shfl_xor(v, o);
    return v;
}
template <int CTRL, int ROWMASK> __device__ __forceinline__ float dpp_f(float v) { return __int_as_float(__builtin_amdgcn_update_dpp(0, __float_as_int(v), CTRL, ROWMASK, 0xF, true)); }
__device__ __forceinline__ float wave_sum_dpp(float v) {
    v += dpp_f<0xB1, 0xF>(v); v += dpp_f<0x4E, 0xF>(v); v += dpp_f<0x141, 0xF>(v); v += dpp_f<0x140, 0xF>(v);
    v += dpp_f<0x142, 0xA>(v); v += dpp_f<0x143, 0xC>(v);
    return __int_as_float(__builtin_amdgcn_readlane(__float_as_int(v), 63));
}
__device__ __forceinline__ float sigmoidf_(float x) { return __builtin_amdgcn_rcpf(1.0f + __builtin_amdgcn_exp2f(x * -1.4426950408889634f)); }
__device__ __forceinline__ float siluf_(float x) { return x * sigmoidf_(x); }
__device__ __forceinline__ float gelu_tanh(float x) { const float u = 1.5957691216057308f * (x + 0.044715f * x * x * x); return x * sigmoidf_(u); }

#define XB_TMO      128
#define XB_XCNT(j)  (256  + 64 * (j))
#define XB_XSUB(j)  (1280 + 64 * (j))
#define XB_XGEN(j)  (2304 + 64 * (j))
#define XB_TOP      3328
#define XB_TOPGEN   3392
#define XCD_BAR_WORDS 3456
#define XB_SPIN_CAP (1u << 18)
__device__ __forceinline__ unsigned xb_ld(unsigned* p)              { return __hip_atomic_load(p, __ATOMIC_RELAXED, __HIP_MEMORY_SCOPE_AGENT); }
__device__ __forceinline__ unsigned xb_add(unsigned* p, unsigned v) { return __hip_atomic_fetch_add(p, v, __ATOMIC_RELAXED, __HIP_MEMORY_SCOPE_AGENT); }
__device__ __forceinline__ unsigned xb_xcc_id() { return (unsigned)__builtin_amdgcn_s_getreg((3 << 11) | 20) & 0xFu; }
#define XB_SPIN(cond, bar) do { unsigned _sp = 0; while (cond) { __builtin_amdgcn_s_sleep(1); \
    if ((++_sp & 255u) == 0u) { if (xb_ld(&(bar)[XB_TMO])) break; if (_sp > XB_SPIN_CAP) { atomicAdd(&(bar)[XB_TMO], 1u); break; } } } } while (0)
struct XcdBarrier { unsigned* bar; unsigned x; volatile LAS unsigned* st; };
__device__ __forceinline__ XcdBarrier xcd_barrier_post(unsigned* bar, volatile LAS unsigned* st) {
    XcdBarrier b; b.bar = bar; b.x = xb_xcc_id(); b.st = st;
    if (threadIdx.x == 0) (void)xb_add(&bar[XB_XCNT(b.x)], 1u);
    return b;
}
__device__ __forceinline__ void xcd_barrier_complete(unsigned* bar, unsigned x, unsigned& nloc, unsigned& nx) {
    const unsigned G = gridDim.x * gridDim.y * gridDim.z;
    unsigned sum, cnt, mine, sp = 0u;
    for (;;) {
        sum = 0u; cnt = 0u; mine = 0u;
#pragma unroll
        for (unsigned j = 0; j < 16; ++j) { const unsigned c = xb_ld(&bar[XB_XCNT(j)]); sum += c; cnt += (c > 0u) ? 1u : 0u; mine = (j == x) ? c : mine; }
        if (sum == G) break;
        __builtin_amdgcn_s_sleep(1);
        if ((++sp & 255u) == 0u) { if (xb_ld(&bar[XB_TMO])) break; if (sp > XB_SPIN_CAP) { atomicAdd(&bar[XB_TMO], 1u); break; } }
    }
    nloc = mine > 0u ? mine : 1u; nx = cnt > 0u ? cnt : 1u;
}
__device__ __forceinline__ void xcd_barrier(const XcdBarrier& b) {
    asm volatile("s_waitcnt vmcnt(0)" ::: "memory");
    __syncthreads();
    if (threadIdx.x == 0) {
        unsigned* bar = b.bar;
        __builtin_amdgcn_s_waitcnt(0);
        unsigned nloc = b.st[0], nx = b.st[1];
        if (nloc == 0u) { xcd_barrier_complete(bar, b.x, nloc, nx); b.st[0] = nloc; b.st[1] = nx; }
        const unsigned old = xb_add(&bar[XB_XSUB(b.x)], 1u);
        const unsigned gen = old / nloc;
        if (old + 1u == (gen + 1u) * nloc) {
            __builtin_amdgcn_fence(__ATOMIC_RELEASE, "agent");
            asm volatile("s_waitcnt vmcnt(0)" ::: "memory");
            const unsigned og = xb_add(&bar[XB_TOP], 1u);
            const unsigned tg = og / nx;
            if (og + 1u == (tg + 1u) * nx) xb_add(&bar[XB_TOPGEN], 1u);
            else XB_SPIN(xb_ld(&bar[XB_TOPGEN]) == tg, bar);
            __builtin_amdgcn_fence(__ATOMIC_ACQUIRE, "agent");
            xb_add(&bar[XB_XGEN(b.x)], 1u);
            asm volatile("s_waitcnt vmcnt(0)" ::: "memory");
        } else {
            XB_SPIN(xb_ld(&bar[XB_XGEN(b.x)]) == gen, bar);
            __builtin_amdgcn_fence(__ATOMIC_ACQUIRE, "agent");
            asm volatile("s_waitcnt vmcnt(0)" ::: "memory");
        }
    }
    __syncthreads();
}

namespace pg8 {
constexpr int BM = 256, BK = 64, HALF = 128, HTB = HALF * BK * 2, STAGE_BYTES = 8 * HTB, NXCD = 8, WGM = 8;
__host__ __device__ __forceinline__ int lds_byte(int r, int c) { const int st = (r >> 4) * 2 + (c >> 5), rr = r & 15, cc = c & 31, ob = rr * 64 + cc * 2; return st * 1024 + (ob ^ (((ob >> 9) & 1) << 5)); }
__host__ __device__ __forceinline__ void stage_rc(int b, int& R, int& C) { const int st = b / 1024, sb = b % 1024, swz = sb ^ (((sb >> 9) & 1) << 5); R = (st >> 1) * 16 + swz / 64; C = (st & 1) * 32 + (swz % 64) / 2; }
__host__ __device__ __forceinline__ int perm32(int rho) { const int n = rho >> 4, i = rho & 15; return 8 * (i >> 2) + 4 * n + (i & 3); }
struct Unit { int pm, pn, k0, nt, slab; };

struct Sched {
    int nM, nN, nwg, G, c, ntot, S;
    const char* A; size_t a_tile, a_pn; const char* B; size_t b_tile, b_exp; const int* tile_e; const int* gather;
    __device__ __forceinline__ void init(int nM_, int nN_, int G_, int c_, int ntot_, bool split = false, int min_S = 2) {   nM = nM_; nN = nN_; nwg = nM * nN; G = G_; c = c_; ntot = ntot_; a_pn = 0; b_exp = 0; tile_e = nullptr; gather = nullptr;
        S = 1; if (split) { const int T = nwg % G; if (T > 0) { int s = G / T; if (s > 8) s = 8; if (s > ntot / 4) s = ntot / 4; if (s > 1 && s >= min_S) S = s; } } }
    __device__ __forceinline__ void map(long L, Unit& u) const {
        int wgid = (int)L; { const int q = nwg / NXCD, r = nwg % NXCD, xcd = wgid % NXCD, off = wgid / NXCD; wgid = (xcd < r ? xcd * (q + 1) : r * (q + 1) + (xcd - r) * q) + off; }
        const int nig = WGM * nN, gid = wgid / nig, fm = gid * WGM, gsz = (nM - fm) < WGM ? (nM - fm) : WGM;
        u.pm = fm + ((wgid % nig) % gsz); u.pn = (wgid % nig) / gsz; }
    __device__ __forceinline__ bool next(int i, Unit& u) const {
        if (S > 1) { const int R = nwg / G, T = nwg - R * G;
            if (i > R) return false;
            if (i == R) { if (c >= T * S) return false; const int tu = c % T, s = c / T; map((long)R * G + tu, u);
                const int base = (ntot / S) & ~1, rem2 = (ntot - base * S) >> 1; u.nt = base + (s < rem2 ? 2 : 0); u.k0 = s * base + 2 * (s < rem2 ? s : rem2); u.slab = s * T + tu; return true; } }
        const long L = (long)i * G + c; if (L >= nwg) return false;
        map(L, u); u.k0 = 0; u.nt = ntot; u.slab = -1; return true;
    }
    __device__ __forceinline__ const char* a_base(const Unit& u) const { return A + (size_t)u.pm * a_tile + (size_t)u.pn * a_pn + (size_t)u.k0 * 128; }
    __device__ __forceinline__ const char* b_base(const Unit& u) const { const int e = tile_e ? __builtin_amdgcn_readfirstlane(tile_e[u.pm]) : 0; return B + (size_t)e * b_exp + (size_t)u.pn * b_tile + (size_t)u.k0 * 128; }
};

constexpr int GATHER_LDS_OFF = 131072, GATHER_MAX_UNITS = 28;
template <class Epi, bool ALIGN_EPI = true, bool GATHER = false>
__device__ __forceinline__ void gemm_phase(LAS unsigned char* lds, const int K, const int lda, const Sched& S, const Epi& E) {
    int tid_ = threadIdx.x; asm volatile("" : "+v"(tid_));
    const int tid = tid_, wid = __builtin_amdgcn_readfirstlane(tid >> 6), lane = tid & 63, wr = wid >> 2, wc = wid & 3, fr = lane & 15, fq = lane >> 4;
    unsigned voffA[2][2], voffAn[2][2], voffB[2]; int aoff, boff;
#define PG8_LANECONST() do { int t_ = tid; asm volatile("" : "+v"(t_)); const int l_ = t_ & 63, fr_ = l_ & 15, fq_ = l_ >> 4; \
    _Pragma("unroll") for (int i = 0; i < 2; ++i) { int R, C; stage_rc(t_ * 16 + i * 8192, R, C); const int Rb = Epi::PERM ? ((R & ~31) + perm32(R & 31)) : R; \
        if (!GATHER) { voffA[0][i] = (unsigned)(R * lda + C) * 2u; voffA[1][i] = (unsigned)((R + HALF) * lda + C) * 2u; voffAn[0][i] = voffA[0][i]; voffAn[1][i] = voffA[1][i]; } voffB[i] = (unsigned)(Rb * K + C) * 2u; } \
    aoff = lds_byte(wr * 64 + fr_, fq_ * 8); boff = lds_byte(wc * 32 + fr_, fq_ * 8); } while (0)
    PG8_LANECONST();
#define PG8_GATHER_OFFS(dst, ui_) do { int t_ = tid; asm volatile("" : "+v"(t_)); _Pragma("unroll") for (int i = 0; i < 2; ++i) { int R, C; stage_rc(t_ * 16 + i * 8192, R, C); \
        const LAS int* gt_ = (const LAS int*)(lds + GATHER_LDS_OFF) + (ui_) * 256; dst[0][i] = (unsigned)(gt_[R] * lda + C) * 2u; dst[1][i] = (unsigned)(gt_[R + HALF] * lda + C) * 2u; } } while (0)
    if constexpr (GATHER) { Unit u_; for (int i = 0; i < GATHER_MAX_UNITS && S.next(i, u_); ++i) { if (tid < 256) ((LAS int*)(lds + GATHER_LDS_OFF))[i * 256 + tid] = S.gather[u_.pm * 256 + tid]; }
        asm volatile("s_waitcnt vmcnt(0) lgkmcnt(0)" ::: "memory"); __builtin_amdgcn_s_barrier(); PG8_GATHER_OFFS(voffA, 0); }
    const size_t kstep = (size_t)(BK * 2);
    const size_t hstepB = (size_t)HALF * K * 2;
    const unsigned ldsw = (unsigned)wid * 1024u;
#define PG8_SA(b, h) (((b) * 2 + (h)) * HTB)
#define PG8_SB(b, h) ((4 + (b) * 2 + (h)) * HTB)
#define PG8_STAGE(bufoff, gbase, voff) do { _Pragma("unroll") for (int _i = 0; _i < 2; ++_i) \
        __builtin_amdgcn_global_load_lds((const unsigned*)((const char*)(gbase) + (voff)[_i]), (LAS unsigned*)(lds + (bufoff) + ldsw + _i * 8192), 16, 0, 0); } while (0)
#define PG8_LDA(dst, b, h) do { _Pragma("unroll") for (int m = 0; m < 4; ++m) _Pragma("unroll") for (int k = 0; k < 2; ++k) dst[m][k] = *(const LAS bf16x8*)(lds + PG8_SA(b, h) + aoff + m * 2048 + k * 1024); } while (0)
#define PG8_LDB(dst, b, h) do { _Pragma("unroll") for (int n = 0; n < 2; ++n) _Pragma("unroll") for (int k = 0; k < 2; ++k) dst[n][k] = *(const LAS bf16x8*)(lds + PG8_SB(b, h) + boff + n * 2048 + k * 1024); } while (0)
#define PG8_MMA(ai, bj, At, Bt) do { __builtin_amdgcn_s_setprio(1); _Pragma("unroll") for (int m = 0; m < 4; ++m) _Pragma("unroll") for (int n = 0; n < 2; ++n) _Pragma("unroll") for (int k = 0; k < 2; ++k) \
        acc[ai][bj][m][n] = __builtin_amdgcn_mfma_f32_16x16x32_bf16(Bt[n][k], At[m][k], acc[ai][bj][m][n], 0, 0, 0); __builtin_amdgcn_s_setprio(0); } while (0)
#define PG8_WAIT_V(n) asm volatile("s_waitcnt vmcnt(" #n ")" ::: "memory")
#define PG8_WAIT_L(n) asm volatile("s_waitcnt lgkmcnt(" #n ")" ::: "memory")
#define PG8_BAR __builtin_amdgcn_s_barrier()
#define PG8_SCHED __builtin_amdgcn_sched_barrier(0)
    Unit cur, nxt; int ui = 0;
    if (!S.next(0, cur)) return;
    int nt = cur.nt;
    f32x4 acc[2][2][4][2];
#pragma unroll
    for (int a = 0; a < 2; ++a)
#pragma unroll
        for (int b = 0; b < 2; ++b)
#pragma unroll
            for (int m = 0; m < 4; ++m)
#pragma unroll
                for (int n = 0; n < 2; ++n) acc[a][b][m][n] = (f32x4){0.f, 0.f, 0.f, 0.f};
    bf16x8 At[4][2], B0[2][2], B1[2][2];
    const char* cA = S.a_base(cur); const char* cB = S.b_base(cur);
    PG8_STAGE(PG8_SB(0, 0), cB, voffB); PG8_STAGE(PG8_SB(0, 1), cB + hstepB, voffB); PG8_STAGE(PG8_SA(0, 0), cA, voffA[0]); PG8_STAGE(PG8_SA(0, 1), cA, voffA[1]);
    if (wr == 1) PG8_BAR;
    PG8_WAIT_V(2); PG8_BAR;
    PG8_STAGE(PG8_SB(1, 0), cB + kstep, voffB); PG8_STAGE(PG8_SA(1, 0), cA + kstep, voffA[0]); PG8_STAGE(PG8_SB(1, 1), cB + hstepB + kstep, voffB);
    PG8_WAIT_V(6); PG8_BAR;
    for (;;) {
        const bool has_next = S.next(ui + 1, nxt);
        const char* nA = has_next ? S.a_base(nxt) : cA; const char* nB = has_next ? S.b_base(nxt) : cB;
        if constexpr (GATHER) { if (has_next) PG8_GATHER_OFFS(voffAn, ui + 1); else { _Pragma("unroll") for (int h_ = 0; h_ < 2; ++h_) _Pragma("unroll") for (int i_ = 0; i_ < 2; ++i_) voffAn[h_][i_] = voffA[h_][i_]; } }
        for (int t = 0; t < nt; t += 2) {
            const bool last = (t == nt - 2);
            const char* a1 = cA + (size_t)(t + 1) * kstep;
            const char* a2 = last ? nA : cA + (size_t)(t + 2) * kstep; const char* b2 = last ? nB : cB + (size_t)(t + 2) * kstep;
            const char* a3 = a2 + kstep; const char* b3 = b2 + kstep;
            unsigned vs0[2], vs1[2];
            if constexpr (GATHER) { _Pragma("unroll") for (int i_ = 0; i_ < 2; ++i_) { vs0[i_] = last ? voffAn[0][i_] : voffA[0][i_]; vs1[i_] = last ? voffAn[1][i_] : voffA[1][i_]; } }
            else { _Pragma("unroll") for (int i_ = 0; i_ < 2; ++i_) { vs0[i_] = voffA[0][i_]; vs1[i_] = voffA[1][i_]; } }
            PG8_LDB(B0, 0, 0); PG8_LDB(B1, 0, 1); PG8_SCHED; PG8_LDA(At, 0, 0); PG8_STAGE(PG8_SA(1, 1), a1, voffA[1]);
            PG8_WAIT_V(8); PG8_WAIT_L(0); PG8_BAR; PG8_MMA(0, 0, At, B0); PG8_MMA(0, 1, At, B1); PG8_BAR; PG8_SCHED;
            PG8_LDA(At, 0, 1); PG8_STAGE(PG8_SB(0, 0), b2, voffB); PG8_STAGE(PG8_SB(0, 1), b2 + hstepB, voffB); PG8_STAGE(PG8_SA(0, 0), a2, vs0);
            PG8_WAIT_V(8); PG8_WAIT_L(0); PG8_BAR; PG8_MMA(1, 0, At, B0); PG8_MMA(1, 1, At, B1); PG8_BAR; PG8_SCHED;
            PG8_LDB(B0, 1, 0); PG8_LDB(B1, 1, 1); PG8_SCHED; PG8_LDA(At, 1, 0); PG8_STAGE(PG8_SA(0, 1), a2, vs1);
            PG8_WAIT_V(8); PG8_WAIT_L(0); PG8_BAR; PG8_MMA(0, 0, At, B0); PG8_MMA(0, 1, At, B1); PG8_BAR; PG8_SCHED;
            PG8_LDA(At, 1, 1); PG8_STAGE(PG8_SB(1, 0), b3, voffB); PG8_STAGE(PG8_SB(1, 1), b3 + hstepB, voffB); PG8_STAGE(PG8_SA(1, 0), a3, vs0);
            PG8_WAIT_V(8); PG8_WAIT_L(0); PG8_BAR; PG8_MMA(1, 0, At, B0); PG8_MMA(1, 1, At, B1); PG8_BAR; PG8_SCHED;
        }
        if constexpr (ALIGN_EPI) { if (wr == 0) PG8_BAR; }
        E(acc, cur, wr, wc, fr, fq);
        if (!has_next) break;
#pragma unroll
        for (int a = 0; a < 2; ++a)
#pragma unroll
            for (int b = 0; b < 2; ++b)
#pragma unroll
                for (int m = 0; m < 4; ++m)
#pragma unroll
                    for (int n = 0; n < 2; ++n) acc[a][b][m][n] = (f32x4){0.f, 0.f, 0.f, 0.f};
        cur = nxt; cA = nA; cB = nB; ++ui; nt = cur.nt;
        PG8_LANECONST();
        if constexpr (GATHER) PG8_GATHER_OFFS(voffA, ui);
        if constexpr (ALIGN_EPI) { if (wr == 1) PG8_BAR; }
    }
    PG8_WAIT_V(0);
    if constexpr (!ALIGN_EPI) { if (wr == 0) PG8_BAR; }
    PG8_BAR;
#undef PG8_LANECONST
#undef PG8_GATHER_OFFS
#undef PG8_SA
#undef PG8_SB
#undef PG8_STAGE
#undef PG8_LDA
#undef PG8_LDB
#undef PG8_MMA
#undef PG8_WAIT_V
#undef PG8_WAIT_L
#undef PG8_BAR
#undef PG8_SCHED
}
}

using pg8::Unit;
__device__ __forceinline__ int bidx_of_tile(int pm) { return pm < (NLAT / 256) ? (pm >> 4) : NB; }

struct EpiZ {
    static constexpr bool PERM = true;
    bf16_t* Z; float* SSQ;
    __device__ __forceinline__ void operator()(const f32x4 (&acc)[2][2][4][2], const Unit& u, int wr, int wc, int fr, int fq) const {
        const int row0 = u.pm * 256 + wr * 64 + fr, col0 = u.pn * 256 + wc * 32 + 8 * fq;
#pragma unroll
        for (int ai = 0; ai < 2; ++ai)
#pragma unroll
            for (int m = 0; m < 4; ++m) { const int row = row0 + ai * 128 + m * 16;
#pragma unroll
                for (int bj = 0; bj < 2; ++bj) { const f32x4 v0 = acc[ai][bj][m][0], v1 = acc[ai][bj][m][1];
                    u32x4 w; w.x = cvt_pk_bf16(v0[0], v0[1]); w.y = cvt_pk_bf16(v0[2], v0[3]); w.z = cvt_pk_bf16(v1[0], v1[1]); w.w = cvt_pk_bf16(v1[2], v1[3]);
                    *(GAS u32x4*)(Z + (size_t)row * ZW + col0 + bj * 128) = w;
                    float s = (v0[0] * v0[0] + v0[1] * v0[1]) + (v0[2] * v0[2] + v0[3] * v0[3]) + (v1[0] * v1[0] + v1[1] * v1[1]) + (v1[2] * v1[2] + v1[3] * v1[3]);
                    s += __shfl_xor(s, 16); s += __shfl_xor(s, 32);
                    if (fq == 0) ((GAS float*)SSQ)[(size_t)row * 24 + u.pn * 8 + bj * 4 + wc] = s; } }
    }
};
__device__ __forceinline__ float rstd_q_of(const float* SSQ, int row) { const GAS f32x4* p = (const GAS f32x4*)(SSQ + (size_t)row * 24); const f32x4 a = p[0], b = p[1], c = p[2];
    const float s = ((a[0] + a[1]) + (a[2] + a[3])) + ((b[0] + b[1]) + (b[2] + b[3])) + ((c[0] + c[1]) + (c[2] + c[3])); return rsqrtf(s * (1.0f / QLORA) + EPS); }
__device__ __forceinline__ float rstd_kv_of(const float* SSQ, int row) { const GAS f32x4* p = (const GAS f32x4*)(SSQ + (size_t)row * 24); const f32x4 a = p[3], b = p[4];
    const float s = ((a[0] + a[1]) + (a[2] + a[3])) + ((b[0] + b[1]) + (b[2] + b[3])); return rsqrtf(s * (1.0f / KVLORA) + EPS); }

struct EpiQ {
    static constexpr bool PERM = true;
    bf16_t* Q; const float* SSQ; const f32x2* ROPE_T;
    __device__ __forceinline__ void operator()(const f32x4 (&acc)[2][2][4][2], const Unit& u, int wr, int wc, int fr, int fq) const {
        const int row0 = u.pm * 256 + wr * 64 + fr, col0 = u.pn * 256 + wc * 32 + 8 * fq;
        const bool latent = u.pm < (NLAT / 256);
#pragma unroll
        for (int ai = 0; ai < 2; ++ai) {
            float rs4[4];
#pragma unroll
            for (int m = 0; m < 4; ++m) rs4[m] = rstd_q_of(SSQ, row0 + ai * 128 + m * 16) * ATT_C2;
#pragma unroll
            for (int m = 0; m < 4; ++m) { const int row = row0 + ai * 128 + m * 16; const float rs = rs4[m]; const int t = row & (SEQ - 1);
#pragma unroll
                for (int bj = 0; bj < 2; ++bj) { const int cb = col0 + bj * 128; const int d0 = cb % QKD;
                    float v[8];
#pragma unroll
                    for (int j = 0; j < 4; ++j) { v[j] = acc[ai][bj][m][0][j] * rs; v[4 + j] = acc[ai][bj][m][1][j] * rs; }
                    if (latent && d0 >= 64) {
                        const int dd = d0 - 64; const float pos = (float)((dd >> 4) == 0 ? (t >> 6) : (t & 63));
                        const float pr = pos * ((dd & 8) ? 0.01f : 1.0f) * 0.15915494309189535f;
                        const float r0 = pr, r1 = pr * 0.31622776601683794f, r2 = pr * 0.1f, r3 = pr * 0.031622776601683794f;
                        const float c0 = __builtin_amdgcn_cosf(r0), s0 = __builtin_amdgcn_sinf(r0), c1 = __builtin_amdgcn_cosf(r1), s1 = __builtin_amdgcn_sinf(r1);
                        const float c2 = __builtin_amdgcn_cosf(r2), s2 = __builtin_amdgcn_sinf(r2), c3 = __builtin_amdgcn_cosf(r3), s3 = __builtin_amdgcn_sinf(r3);
                        float x1, x2;
                        x1 = v[0]; x2 = v[1]; v[0] = x1 * c0 - x2 * s0; v[1] = x2 * c0 + x1 * s0;
                        x1 = v[2]; x2 = v[3]; v[2] = x1 * c1 - x2 * s1; v[3] = x2 * c1 + x1 * s1;
                        x1 = v[4]; x2 = v[5]; v[4] = x1 * c2 - x2 * s2; v[5] = x2 * c2 + x1 * s2;
                        x1 = v[6]; x2 = v[7]; v[6] = x1 * c3 - x2 * s3; v[7] = x2 * c3 + x1 * s3; }
                    u32x4 w; w.x = cvt_pk_bf16(v[0], v[1]); w.y = cvt_pk_bf16(v[2], v[3]); w.z = cvt_pk_bf16(v[4], v[5]); w.w = cvt_pk_bf16(v[6], v[7]);
                    *(GAS u32x4*)(Q + (size_t)row * (NHEAD * QKD) + cb) = w; } }
            asm volatile("" ::: "memory"); }
    }
};
struct EpiKV {
    static constexpr bool PERM = true;
    bf16_t* Kb; bf16_t* Vb; const float* SSQ;
    __device__ __forceinline__ void operator()(const f32x4 (&acc)[2][2][4][2], const Unit& u, int wr, int wc, int fr, int fq) const {
        const int row0 = u.pm * 256 + wr * 64 + fr;
#pragma unroll
        for (int ai = 0; ai < 2; ++ai) { float rs4[4];
#pragma unroll
            for (int m = 0; m < 4; ++m) rs4[m] = rstd_kv_of(SSQ, row0 + ai * 128 + m * 16);
#pragma unroll
            for (int m = 0; m < 4; ++m) { const int row = row0 + ai * 128 + m * 16; const float rs = rs4[m];
#pragma unroll
                for (int bj = 0; bj < 2; ++bj) { const int head = u.pn * 2 + bj; const int j0 = wc * 32 + 8 * fq;
                    const f32x4 v0 = acc[ai][bj][m][0] * rs, v1 = acc[ai][bj][m][1] * rs;
                    u32x4 w; w.x = cvt_pk_bf16(v0[0], v0[1]); w.y = cvt_pk_bf16(v0[2], v0[3]); w.z = cvt_pk_bf16(v1[0], v1[1]); w.w = cvt_pk_bf16(v1[2], v1[3]);
                    bf16_t* dst = ((j0 < 64) ? Kb : Vb) + (size_t)row * (NHEAD * VD) + head * VD + (j0 & 63);
                    *(u32x4*)dst = w; } }
            asm volatile("" ::: "memory"); }
    }
};
__device__ __forceinline__ f32x4 bf4_lo(const u32x4 w) { return (f32x4){__builtin_bit_cast(float, w.x << 16), __builtin_bit_cast(float, w.x & 0xffff0000u), __builtin_bit_cast(float, w.y << 16), __builtin_bit_cast(float, w.y & 0xffff0000u)}; }
__device__ __forceinline__ f32x4 bf4_hi(const u32x4 w) { return (f32x4){__builtin_bit_cast(float, w.z << 16), __builtin_bit_cast(float, w.z & 0xffff0000u), __builtin_bit_cast(float, w.w << 16), __builtin_bit_cast(float, w.w & 0xffff0000u)}; }
template <bool PS> struct EpiResidT {
    static constexpr bool PERM = true;
    bf16_t* X; const float* gate; const float* pscale; float* SLAB;
    __device__ __forceinline__ void operator()(const f32x4 (&acc)[2][2][4][2], const Unit& u, int wr, int wc, int fr, int fq) const {
        const int row0 = u.pm * 256 + wr * 64 + fr, col0 = u.pn * 256 + wc * 32 + 8 * fq;
        const float* g = gate + (size_t)bidx_of_tile(u.pm) * 6144;
        f32x4 gv[2][2];
#pragma unroll
        for (int bj = 0; bj < 2; ++bj)
#pragma unroll
            for (int n = 0; n < 2; ++n) { gv[bj][n] = *(const GAS f32x4*)(g + col0 + bj * 128 + n * 4); if (PS) gv[bj][n] = gv[bj][n] * *(const GAS f32x4*)(pscale + col0 + bj * 128 + n * 4); }
        if (u.slab >= 0) {
            bf16_t* sp = (bf16_t*)SLAB + ((size_t)u.slab * 256 + wr * 64 + fr) * 256 + wc * 32 + 8 * fq;
#pragma unroll
            for (int ai = 0; ai < 2; ++ai)
#pragma unroll
                for (int m = 0; m < 4; ++m)
#pragma unroll
                    for (int bj = 0; bj < 2; ++bj) { const f32x4 a = gv[bj][0] * acc[ai][bj][m][0], b = gv[bj][1] * acc[ai][bj][m][1];
                        u32x4 w; w.x = cvt_pk_bf16(a[0], a[1]); w.y = cvt_pk_bf16(a[2], a[3]); w.z = cvt_pk_bf16(b[0], b[1]); w.w = cvt_pk_bf16(b[2], b[3]);
                        *(GAS u32x4*)(sp + (size_t)(ai * 128 + m * 16) * 256 + bj * 128) = w; }
            return; }
        u32x4 xv[2][4][2];
#pragma unroll
        for (int ai = 0; ai < 2; ++ai)
#pragma unroll
            for (int m = 0; m < 4; ++m)
#pragma unroll
                for (int bj = 0; bj < 2; ++bj) xv[ai][m][bj] = *(const GAS u32x4*)(X + (size_t)(row0 + ai * 128 + m * 16) * DM + col0 + bj * 128);
#pragma unroll
        for (int ai = 0; ai < 2; ++ai)
#pragma unroll
            for (int m = 0; m < 4; ++m)
#pragma unroll
                for (int bj = 0; bj < 2; ++bj) { const f32x4 a = bf4_lo(xv[ai][m][bj]) + gv[bj][0] * acc[ai][bj][m][0], b = bf4_hi(xv[ai][m][bj]) + gv[bj][1] * acc[ai][bj][m][1];
                    u32x4 w; w.x = cvt_pk_bf16(a[0], a[1]); w.y = cvt_pk_bf16(a[2], a[3]); w.z = cvt_pk_bf16(b[0], b[1]); w.w = cvt_pk_bf16(b[2], b[3]);
                    *(GAS u32x4*)(X + (size_t)(row0 + ai * 128 + m * 16) * DM + col0 + bj * 128) = w; }
    }
};
typedef EpiResidT<false> EpiResid;
struct EpiSwiGLU {
    static constexpr bool PERM = true;
    bf16_t* ACT;
    __device__ __forceinline__ void operator()(const f32x4 (&acc)[2][2][4][2], const Unit& u, int wr, int wc, int fr, int fq) const {
        const int row0 = u.pm * 256 + wr * 64 + fr, col0 = u.pn * 128 + wc * 32 + 8 * fq;
#pragma unroll
        for (int ai = 0; ai < 2; ++ai)
#pragma unroll
            for (int m = 0; m < 4; ++m) { float o[8];
#pragma unroll
                for (int n = 0; n < 2; ++n)
#pragma unroll
                    for (int j = 0; j < 4; ++j) o[n * 4 + j] = siluf_(acc[ai][0][m][n][j]) * acc[ai][1][m][n][j];
                u32x4 w; w.x = cvt_pk_bf16(o[0], o[1]); w.y = cvt_pk_bf16(o[2], o[3]); w.z = cvt_pk_bf16(o[4], o[5]); w.w = cvt_pk_bf16(o[6], o[7]);
                *(GAS u32x4*)(ACT + (size_t)(row0 + ai * 128 + m * 16) * FFN + col0) = w; }
    }
};
struct EpiGLU {
    static constexpr bool PERM = true;
    bf16_t* X; const float* gate;
    __device__ __forceinline__ void operator()(const f32x4 (&acc)[2][2][4][2], const Unit& u, int wr, int wc, int fr, int fq) const {
        const int row0 = u.pm * 256 + wr * 64 + fr, col0 = u.pn * 128 + wc * 32 + 8 * fq;
        const float* g = gate + (size_t)bidx_of_tile(u.pm) * 6144;
        f32x4 gv[2];
#pragma unroll
        for (int n = 0; n < 2; ++n) gv[n] = *(const GAS f32x4*)(g + col0 + n * 4);
        u32x4 xv[2][4];
#pragma unroll
        for (int ai = 0; ai < 2; ++ai)
#pragma unroll
            for (int m = 0; m < 4; ++m) xv[ai][m] = *(const GAS u32x4*)(X + (size_t)(row0 + ai * 128 + m * 16) * DM + col0);
#pragma unroll
        for (int ai = 0; ai < 2; ++ai)
#pragma unroll
            for (int m = 0; m < 4; ++m) { f32x4 o0, o1;
#pragma unroll
                for (int j = 0; j < 4; ++j) { o0[j] = acc[ai][0][m][0][j] * sigmoidf_(acc[ai][1][m][0][j]); o1[j] = acc[ai][0][m][1][j] * sigmoidf_(acc[ai][1][m][1][j]); }
                const f32x4 a = bf4_lo(xv[ai][m]) + gv[0] * o0, b = bf4_hi(xv[ai][m]) + gv[1] * o1;
                u32x4 w; w.x = cvt_pk_bf16(a[0], a[1]); w.y = cvt_pk_bf16(a[2], a[3]); w.z = cvt_pk_bf16(b[0], b[1]); w.w = cvt_pk_bf16(b[2], b[3]);
                *(GAS u32x4*)(X + (size_t)(row0 + ai * 128 + m * 16) * DM + col0) = w; }
    }
};
struct EpiBf16 {
    static constexpr bool PERM = true;
    bf16_t* O; int ldc; float* SLAB;
    __device__ __forceinline__ void operator()(const f32x4 (&acc)[2][2][4][2], const Unit& u, int wr, int wc, int fr, int fq) const {
        const int row0 = u.pm * 256 + wr * 64 + fr, col0 = u.pn * 256 + wc * 32 + 8 * fq;
        if (u.slab >= 0) { bf16_t* sp = (bf16_t*)SLAB + ((size_t)u.slab * 256 + wr * 64 + fr) * 256 + wc * 32 + 8 * fq;
#pragma unroll
            for (int ai = 0; ai < 2; ++ai)
#pragma unroll
                for (int m = 0; m < 4; ++m)
#pragma unroll
                    for (int bj = 0; bj < 2; ++bj) { const f32x4 v0 = acc[ai][bj][m][0], v1 = acc[ai][bj][m][1]; u32x4 w; w.x = cvt_pk_bf16(v0[0], v0[1]); w.y = cvt_pk_bf16(v0[2], v0[3]); w.z = cvt_pk_bf16(v1[0], v1[1]); w.w = cvt_pk_bf16(v1[2], v1[3]);
                        *(GAS u32x4*)(sp + (size_t)(ai * 128 + m * 16) * 256 + bj * 128) = w; }
            return; }
#pragma unroll
        for (int ai = 0; ai < 2; ++ai)
#pragma unroll
            for (int m = 0; m < 4; ++m)
#pragma unroll
                for (int bj = 0; bj < 2; ++bj) { const f32x4 v0 = acc[ai][bj][m][0], v1 = acc[ai][bj][m][1];
                    u32x4 w; w.x = cvt_pk_bf16(v0[0], v0[1]); w.y = cvt_pk_bf16(v0[2], v0[3]); w.z = cvt_pk_bf16(v1[0], v1[1]); w.w = cvt_pk_bf16(v1[2], v1[3]);
                    *(GAS u32x4*)(O + (size_t)(row0 + ai * 128 + m * 16) * ldc + col0 + bj * 128) = w; }
    }
};

namespace att {
constexpr int KSLOT = 12288, VSLOT = 8192;
constexpr int NSK = 4, NSV = 4;
constexpr int LDS_K = 0, LDS_V = NSK * KSLOT, LDS_WS = LDS_V + NSV * VSLOT, LDS_OST = LDS_WS + 8 * 64 * 4, LDS_BYTES = LDS_OST + 8 * 4096;
static_assert(LDS_BYTES <= 131072, "attention LDS");
constexpr float C2 = 0.10206207261596577f * 1.4426950408889634f;
constexpr float THRL = 8.f;
#define SBAR() __builtin_amdgcn_sched_barrier(0)
__device__ __forceinline__ int crow(int r, int hi) { return (r & 3) + 8 * (r >> 2) + 4 * hi; }
__device__ __forceinline__ float max3f(float a, float b, float c) { return __builtin_fmaxf(__builtin_fmaxf(a, b), c); }
__device__ __forceinline__ float rowmax32(const f32x16& p0, const f32x16& p1) {
    float a = max3f(p0[0], p0[1], p1[0]), b = max3f(p0[2], p0[3], p1[1]); a = max3f(a, p1[2], p1[3]);
#pragma unroll
    for (int r = 4; r < 16; r += 4) { a = max3f(a, p0[r], p0[r + 1]); b = max3f(b, p0[r + 2], p0[r + 3]); a = max3f(a, p1[r], p1[r + 1]); b = max3f(b, p1[r + 2], p1[r + 3]); }
    float m = __builtin_fmaxf(a, b);
    auto rr = __builtin_amdgcn_permlane32_swap(__float_as_uint(m), __float_as_uint(m), false, false);
    return __builtin_fmaxf(__uint_as_float(rr[0]), __uint_as_float(rr[1]));
}
__device__ __forceinline__ void wait_bar(int n) {
    switch (n) {
        case 0: asm volatile("s_waitcnt vmcnt(0) lgkmcnt(0)\n\ts_barrier" ::: "memory"); break;
        case 1: asm volatile("s_waitcnt vmcnt(1) lgkmcnt(0)\n\ts_barrier" ::: "memory"); break;
        case 2: asm volatile("s_waitcnt vmcnt(2) lgkmcnt(0)\n\ts_barrier" ::: "memory"); break;
        case 3: asm volatile("s_waitcnt vmcnt(3) lgkmcnt(0)\n\ts_barrier" ::: "memory"); break;
        case 4: asm volatile("s_waitcnt vmcnt(4) lgkmcnt(0)\n\ts_barrier" ::: "memory"); break;
        case 5: asm volatile("s_waitcnt vmcnt(5) lgkmcnt(0)\n\ts_barrier" ::: "memory"); break;
        default: asm volatile("s_waitcnt vmcnt(6) lgkmcnt(0)\n\ts_barrier" ::: "memory"); break;
    }
}
#define WAITBAR(n) wait_bar(n)
__device__ __forceinline__ s16x4 vtr(const LAS unsigned char* p) { typedef short v4i16_t __attribute__((ext_vector_type(4))); return __builtin_bit_cast(s16x4, __builtin_amdgcn_ds_read_tr16_b64_v4i16((LAS v4i16_t*)p)); }

__device__ __forceinline__ void attn_unit(const bf16_t* __restrict__ Qb, const bf16_t* __restrict__ Kb, const bf16_t* __restrict__ Vb, bf16_t* __restrict__ Ob,
                                          const bf16_t* __restrict__ KRb, int qrow0, int kctx0, int klat0, int h, int NT, LAS unsigned char* lds) {
    int tid_ = threadIdx.x; asm volatile("" : "+v"(tid_));
    const int tid = tid_, lane = tid & 63, r32 = lane & 31, hi = lane >> 5; const int wid = __builtin_amdgcn_readfirstlane(tid >> 6);
    LAS float* wsf = (LAS float*)(lds + LDS_WS) + wid * 64;
    const int nk = wid < 4 ? 2 : 1;
    const bf16_t* ksrc = Kb + (size_t)lane * (NHEAD * VD) + h * VD + wid * 8;
    const bf16_t* krsrc = KRb + (size_t)lane * 32 + (wid & 3) * 8;
    const bf16_t* vsrc = Vb + (size_t)(16 * (wid & 3) + (lane >> 2)) * (NHEAD * VD) + h * VD + (wid >> 2) * 32 + (lane & 3) * 8;
#define KROW(t) ((t) < 4 ? kctx0 + (t) * 64 : klat0 + ((t) - 4) * 64)
#define DMA_K(t) do { const size_t kr_ = (size_t)KROW(t); LAS unsigned char* sl_ = lds + LDS_K + ((t) % NSK) * KSLOT; \
        __builtin_amdgcn_global_load_lds((const unsigned*)(ksrc + kr_ * (NHEAD * VD)), (LAS unsigned*)(sl_ + wid * 1024), 16, 0, 0); \
        if (wid < 4) __builtin_amdgcn_global_load_lds((const unsigned*)(krsrc + kr_ * 32), (LAS unsigned*)(sl_ + (wid + 8) * 1024), 16, 0, 0); } while (0)
#define DMA_V(t) do { const size_t ro_ = (size_t)KROW(t) * (NHEAD * VD); __builtin_amdgcn_global_load_lds((const unsigned*)(vsrc + ro_), (LAS unsigned*)(lds + LDS_V + ((t) % NSV) * VSLOT + wid * 1024), 16, 0, 0); } while (0)
    const LAS unsigned char* kp0 = lds + LDS_K + hi * 1024 + r32 * 16;
    const LAS unsigned char* vp0 = lds + LDS_V + ((lane >> 4) & 1) * 32 + (lane & 3) * 8 + (4 * hi + ((lane & 15) >> 2)) * 64;
    float mhat = 0.f; f32x16 o[3]; o[0] = f32x16{}; o[1] = f32x16{}; o[2] = f32x16{}; f32x16 negm = f32x16{}; asm volatile("" : "+v"(negm));
    const bf16x8 ones8 = {0x3F80, 0x3F80, 0x3F80, 0x3F80, 0x3F80, 0x3F80, 0x3F80, 0x3F80};
    bool resc = false;
    DMA_K(0); DMA_V(0); DMA_K(1); DMA_V(1); DMA_K(2);
    static_assert(NSK == 4 && NSV == 4, "prologue issues K0..K2, V0..V1");
    bf16x8 qr[6];
    { const bf16_t* Qw = Qb + (size_t)(qrow0 + wid * 32 + r32) * (NHEAD * QKD) + h * QKD + hi * 8;
#pragma unroll
      for (int d0 = 0; d0 < 6; ++d0) qr[d0] = *(const GAS bf16x8*)(Qw + d0 * 16); }
    asm volatile("" : "+v"(qr[0]), "+v"(qr[1]), "+v"(qr[2]), "+v"(qr[3]), "+v"(qr[4]), "+v"(qr[5]));
    WAITBAR(0);
    f32x16 pA0, pA1, pB0, pB1;
#define QKT(C0, C1, t) do { const LAS unsigned char* kb_ = kp0 + ((t) % NSK) * KSLOT; \
        _Pragma("unroll") for (int d0 = 0; d0 < 6; ++d0) { const bf16x8 b0 = *(const LAS bf16x8*)(kb_ + d0 * 2048), b1 = *(const LAS bf16x8*)(kb_ + d0 * 2048 + 512); \
            if (d0 == 0) { C0 = __builtin_amdgcn_mfma_f32_32x32x16_bf16(b0, qr[0], negm, 0, 0, 0); C1 = __builtin_amdgcn_mfma_f32_32x32x16_bf16(b1, qr[0], negm, 0, 0, 0); } \
            else { C0 = __builtin_amdgcn_mfma_f32_32x32x16_bf16(b0, qr[d0], C0, 0, 0, 0); C1 = __builtin_amdgcn_mfma_f32_32x32x16_bf16(b1, qr[d0], C1, 0, 0, 0); } } } while (0)
#define DECIDE(C0, C1, FIRST) do { float rm_ = rowmax32(C0, C1); resc = false; \
        if ((FIRST) || __builtin_expect(__any(rm_ > THRL), 0)) { const float dl_ = (FIRST) ? rm_ : __builtin_fmaxf(rm_, 0.f); mhat += dl_; \
            _Pragma("unroll") for (int r = 0; r < 16; ++r) { C0[r] -= dl_; C1[r] -= dl_; } \
            _Pragma("unroll") for (int r = 0; r < 16; ++r) negm[r] = -mhat; asm volatile("" : "+v"(negm)); \
            if (!(FIRST)) { const float f_ = __builtin_amdgcn_exp2f(-dl_); if (hi == 0) wsf[r32] = f_; resc = true; } } } while (0)
#define EXPS(C0, C1) do { _Pragma("unroll") for (int r = 0; r < 16; ++r) { C0[r] = __builtin_amdgcn_exp2f(C0[r]); C1[r] = __builtin_amdgcn_exp2f(C1[r]); } } while (0)
#define RESC() do { if (resc) { asm volatile("s_waitcnt lgkmcnt(0)" ::: "memory"); \
        _Pragma("unroll") for (int d_ = 0; d_ < 3; ++d_) _Pragma("unroll") for (int r = 0; r < 16; ++r) o[d_][r] *= wsf[crow(r, hi)]; } } while (0)
#define PV(P0, P1, t) do { u32x4 w0_, w1_, w2_, w3_; \
        w0_ = (u32x4){cvt_pk_bf16(P0[0], P0[1]), cvt_pk_bf16(P0[2], P0[3]), cvt_pk_bf16(P0[4], P0[5]), cvt_pk_bf16(P0[6], P0[7])}; \
        w1_ = (u32x4){cvt_pk_bf16(P0[8], P0[9]), cvt_pk_bf16(P0[10], P0[11]), cvt_pk_bf16(P0[12], P0[13]), cvt_pk_bf16(P0[14], P0[15])}; \
        w2_ = (u32x4){cvt_pk_bf16(P1[0], P1[1]), cvt_pk_bf16(P1[2], P1[3]), cvt_pk_bf16(P1[4], P1[5]), cvt_pk_bf16(P1[6], P1[7])}; \
        w3_ = (u32x4){cvt_pk_bf16(P1[8], P1[9]), cvt_pk_bf16(P1[10], P1[11]), cvt_pk_bf16(P1[12], P1[13]), cvt_pk_bf16(P1[14], P1[15])}; \
        const LAS unsigned char* vp_ = vp0 + ((t) % NSV) * VSLOT; \
        _Pragma("unroll") for (int d0 = 0; d0 < 2; ++d0) { \
            const s16x4 l0 = vtr(vp_ + d0 * 4096), h0 = vtr(vp_ + d0 * 4096 + 512), l1 = vtr(vp_ + d0 * 4096 + 1024), h1 = vtr(vp_ + d0 * 4096 + 1536); \
            const s16x4 l2 = vtr(vp_ + d0 * 4096 + 2048), h2 = vtr(vp_ + d0 * 4096 + 2560), l3 = vtr(vp_ + d0 * 4096 + 3072), h3 = vtr(vp_ + d0 * 4096 + 3584); \
            o[d0] = __builtin_amdgcn_mfma_f32_32x32x16_bf16(__builtin_bit_cast(bf16x8, w0_), (bf16x8){l0[0], l0[1], l0[2], l0[3], h0[0], h0[1], h0[2], h0[3]}, o[d0], 0, 0, 0); \
            o[d0] = __builtin_amdgcn_mfma_f32_32x32x16_bf16(__builtin_bit_cast(bf16x8, w1_), (bf16x8){l1[0], l1[1], l1[2], l1[3], h1[0], h1[1], h1[2], h1[3]}, o[d0], 0, 0, 0); \
            o[d0] = __builtin_amdgcn_mfma_f32_32x32x16_bf16(__builtin_bit_cast(bf16x8, w2_), (bf16x8){l2[0], l2[1], l2[2], l2[3], h2[0], h2[1], h2[2], h2[3]}, o[d0], 0, 0, 0); \
            o[d0] = __builtin_amdgcn_mfma_f32_32x32x16_bf16(__builtin_bit_cast(bf16x8, w3_), (bf16x8){l3[0], l3[1], l3[2], l3[3], h3[0], h3[1], h3[2], h3[3]}, o[d0], 0, 0, 0); } \
        o[2] = __builtin_amdgcn_mfma_f32_32x32x16_bf16(__builtin_bit_cast(bf16x8, w0_), ones8, o[2], 0, 0, 0); o[2] = __builtin_amdgcn_mfma_f32_32x32x16_bf16(__builtin_bit_cast(bf16x8, w1_), ones8, o[2], 0, 0, 0); \
        o[2] = __builtin_amdgcn_mfma_f32_32x32x16_bf16(__builtin_bit_cast(bf16x8, w2_), ones8, o[2], 0, 0, 0); o[2] = __builtin_amdgcn_mfma_f32_32x32x16_bf16(__builtin_bit_cast(bf16x8, w3_), ones8, o[2], 0, 0, 0); } while (0)
#define ISSUED(s_) (((s_) + NSK - 1 < NT ? nk : 0) + ((s_) + NSV - 2 < NT ? 1 : 0))
#define STEP_L(C0, C1, P0, P1, t, FIRST) do { \
        if ((t) + NSK - 1 < NT) DMA_K((t) + NSK - 1); if ((t) + NSV - 2 < NT) DMA_V((t) + NSV - 2); \
        QKT(C0, C1, t); \
        if (!(FIRST)) PV(P0, P1, (t) - 1); \
        DECIDE(C0, C1, FIRST); EXPS(C0, C1); \
        WAITBAR(ISSUED(t) + ((t) >= 1 ? ISSUED((t) - 1) : 0)); \
        RESC(); } while (0)
#define STEP_T(C0, C1, P0, P1, t, FIRST, SECOND) do { \
        if ((t) + NSK - 1 < NT) DMA_K((t) + NSK - 1); if ((t) + NSV - 2 < NT) DMA_V((t) + NSV - 2); \
        if (!(FIRST)) { DECIDE(P0, P1, SECOND); EXPS(P0, P1); RESC(); } \
        QKT(C0, C1, t); \
        if (!(FIRST)) PV(P0, P1, (t) - 1); \
        WAITBAR(ISSUED(t) + ((t) >= 1 ? ISSUED((t) - 1) : 0)); } while (0)
    if (wid < 4) {
        STEP_L(pA0, pA1, pB0, pB1, 0, true);
        STEP_L(pB0, pB1, pA0, pA1, 1, false);
        for (int t = 2; t + 1 < NT; t += 2) { STEP_L(pA0, pA1, pB0, pB1, t, false); STEP_L(pB0, pB1, pA0, pA1, t + 1, false); }
        PV(pB0, pB1, NT - 1);
    } else {
        STEP_T(pA0, pA1, pB0, pB1, 0, true, false);
        STEP_T(pB0, pB1, pA0, pA1, 1, false, true);
        for (int t = 2; t + 1 < NT; t += 2) { STEP_T(pA0, pA1, pB0, pB1, t, false, false); STEP_T(pB0, pB1, pA0, pA1, t + 1, false, false); }
        DECIDE(pB0, pB1, false); EXPS(pB0, pB1); RESC();
        PV(pB0, pB1, NT - 1);
    }
    float rli[16];
#pragma unroll
    for (int r = 0; r < 16; ++r) rli[r] = __builtin_amdgcn_rcpf(o[2][r]);
    { LAS bf16_t* stg = (LAS bf16_t*)(lds + LDS_OST) + wid * 2048;
#pragma unroll
      for (int r = 0; r < 16; ++r) { const int orow = crow(r, hi);
#pragma unroll
          for (int d0 = 0; d0 < 2; ++d0) stg[orow * 64 + d0 * 32 + r32] = (bf16_t)f2bf(o[d0][r] * rli[r]); }
      asm volatile("s_waitcnt lgkmcnt(0)" ::: "memory");
      bf16_t* Ow = Ob + (size_t)(qrow0 + wid * 32) * (NHEAD * VD) + h * VD;
#pragma unroll
      for (int i = 0; i < 4; ++i) { const int row = i * 8 + (lane >> 3), ch = lane & 7; const u32x4 v = *(const LAS u32x4*)(stg + row * 64 + ch * 8); *(GAS u32x4*)(Ow + (size_t)row * (NHEAD * VD) + ch * 8) = v; } }
    WAITBAR(0);
#undef KROW
#undef DMA_K
#undef DMA_V
#undef QKT
#undef DECIDE
#undef EXPS
#undef RESC
#undef PV
#undef STEP_L
#undef STEP_T
#undef ISSUED
}
#undef WAITBAR
#undef SBAR
}

#ifndef MOE_SPLIT
#define MOE_SPLIT false
#endif
constexpr size_t MiB = 1u << 20;
constexpr size_t WS_CTL = 0, CTL_ZERO_BYTES = 1 * MiB;
constexpr size_t CTL_BAR = 16384;
constexpr size_t CTL_MOD = 12 * MiB + 131072;
constexpr int MAX_LAUNCH_REGIONS = 64;
static_assert(CTL_BAR + (size_t)MAX_LAUNCH_REGIONS * 3456 * 4 <= CTL_ZERO_BYTES && CTL_MOD + 4 * 9 * 6144 * 4 <= 13 * MiB, "ctl");
constexpr size_t WS_ROPE = 1 * MiB;
constexpr size_t WS_S5FB = 2 * MiB;
constexpr size_t WS_S5MB = 6 * MiB;
constexpr size_t WS_S5EB = 8 * MiB;
constexpr size_t WS_S5L8 = 12 * MiB;
constexpr size_t WS_TOK = 13 * MiB;
constexpr size_t WS_S2R = 14 * MiB + 262144;
constexpr size_t WS_BLKCNT = 15 * MiB;
constexpr size_t WS_TILEE = WS_BLKCNT + 32768;
constexpr size_t WS_SSQ = 16 * MiB;
constexpr size_t WS_W = 20 * MiB;
constexpr size_t W_DQKV = 0;
constexpr size_t W_UQ = W_DQKV + (size_t)ZW * DM * 2;
constexpr size_t W_UKV = W_UQ + (size_t)1536 * QLORA * 2;
constexpr size_t W_O = W_UKV + (size_t)2048 * KVLORA * 2;
constexpr size_t W_MLA_SZ = W_O + (size_t)DM * DM * 2;
constexpr size_t W_GU_SZ = (size_t)2 * FFN * DM * 2, W_DN_SZ = (size_t)DM * FFN * 2, W_FFN_SZ = W_GU_SZ + W_DN_SZ;
constexpr size_t WO_MLA = 0, WO_FFN = WO_MLA + 2 * W_MLA_SZ, WO_MOE = WO_FFN + 2 * W_FFN_SZ, WO_GLU = WO_MOE + 16 * W_FFN_SZ, WO_POOL = WO_GLU + (size_t)2048 * DM * 2, WO_END = WO_POOL + (size_t)4 * 256 * 256 * 2;
constexpr size_t WS_X = WS_W + ((WO_END + MiB - 1) / MiB) * MiB;
constexpr size_t WS_H = WS_X + (size_t)MT * DM * 4;
constexpr size_t WS_BIG = WS_H + (size_t)MT * DM * 2;
constexpr size_t B_Z = 0, B_Q = B_Z + (size_t)MT * ZW * 2, B_K = B_Q + (size_t)MT * 1536 * 2, B_V = B_K + (size_t)MT * DM * 2, B_KR = B_V + (size_t)MT * DM * 2;
constexpr int MAXSLOT = 71680;
constexpr size_t B_XG = 0, B_ACTM = B_XG + (size_t)MAXSLOT * DM * 2, B_END = B_ACTM + (size_t)MAXSLOT * FFN * 2;
constexpr size_t B_G = 0, B_SIN = B_G + (size_t)MT * DM * 2;
constexpr size_t B_SLAB = (size_t)360 * MiB;
static_assert(B_KR + (size_t)MT * 64 <= B_SLAB && (size_t)MT * FFN * 2 <= B_SLAB && B_SLAB + (size_t)64 * MiB <= B_END && B_V + (size_t)MT * DM * 2 <= B_END && B_SIN + (size_t)64 * 2 * 8 * 544 * 128 * 2 <= B_END, "big");
constexpr size_t WS_SLAB2 = WS_BIG + B_END;
constexpr size_t WS_END = WS_SLAB2 + (size_t)64 * MiB;

struct Params { const float* in[33]; float* out; unsigned char* ws; int ph_lo, ph_hi, li, pad; };
struct Frame { LAS unsigned char* lds; int tid, lane, wave, blk, G, gw, NGW; unsigned char* ws; };
__device__ __forceinline__ Frame refresh(const Frame& F0) { Frame F = F0; int t = threadIdx.x; asm volatile("" : "+v"(t)); F.tid = t; F.lane = t & 63; return F; }
enum { I_X = 0, I_C, I_CTX, I_CCTX, I_N1G, I_N2G, I_ADAW, I_ADAB, I_FNG, I_WDQ, I_QNORM, I_WUQ, I_WDKV, I_KVNORM, I_WUKV, I_WO,
       I_S5ARE, I_S5AIM, I_S5LDT, I_S5BRE, I_S5BIM, I_S5CRE, I_S5CIM, I_S5D, I_S5GLU, I_POOLW, I_POOLS, I_FGU, I_FDN, I_MRW, I_MRB, I_MGU, I_MDN };

template <int SRC, bool COMB, int OUT, bool ROUTER, bool SLABS = false>
__device__ __forceinline__ void phase_rows(const Frame& F0, const Params& P, int nrows, const float* gain, const float* mod_shift  ,
                                           const float* mod_comb, int comb_rows, const float* w_router, const float* b_router, int route_rows, int slab_ntot = 0) {
    const Frame F = refresh(F0);
    LAS int* tailmap = (LAS int*)(F.lds + 1024); int slabS = 1, slabT = 0; const float* SLAB = (const float*)(F.ws + WS_BIG + B_SLAB);
    int mS = 1, mT = 0; const float* SLAB2 = (const float*)(F.ws + WS_SLAB2);
    if (COMB) { const int ntm_ = __builtin_amdgcn_readfirstlane(((const int*)(F.ws + WS_TILEE))[511]); pg8::Sched Sd; Sd.init(ntm_, 4, F.G, 0, FFN / 64, MOE_SPLIT, 8); mS = Sd.S; mT = Sd.nwg % F.G; const int Rr = Sd.nwg / F.G;
        for (int i = F.tid; i < ntm_ * 4; i += 512) tailmap[i] = 0;
        __syncthreads();
        if (mS > 1 && F.tid < mT) { pg8::Unit tu_; Sd.map((long)Rr * F.G + F.tid, tu_); tailmap[tu_.pm * 4 + tu_.pn] = F.tid + 1; }
        __syncthreads(); }
    if (SLABS) { pg8::Sched Sd; Sd.init(MT / 256, 4, F.G, 0, slab_ntot, true); slabS = Sd.S; slabT = Sd.nwg % F.G; const int Rr = Sd.nwg / F.G;
        for (int i = F.tid; i < (MT / 256) * 4; i += 512) tailmap[i] = 0;
        __syncthreads();
        if (slabS > 1 && F.tid < slabT) { pg8::Unit tu_; Sd.map((long)Rr * F.G + F.tid, tu_); tailmap[tu_.pm * 4 + tu_.pn] = F.tid + 1; }
        __syncthreads(); }
    bf16_t* X = (bf16_t*)(F.ws + WS_X); bf16_t* H = (bf16_t*)(F.ws + WS_H); const bf16_t* Y = (const bf16_t*)(F.ws + WS_BIG + B_XG);
    int* TOK = (int*)(F.ws + WS_TOK);
    LAS int* hist = (LAS int*)(F.lds);
    LAS float* MS = (LAS float*)(F.lds + 8192); LAS float* MC = MS + 9 * 2048;
    if (OUT != 2) { for (int i = F.tid; i < 9 * 512; i += 512) { const int b_ = i >> 9, q_ = i & 511; *(LAS f32x4*)(MS + b_ * 2048 + q_ * 4) = *(const GAS f32x4*)(mod_shift + (size_t)b_ * 6144 + q_ * 4); } }
    if (COMB) { for (int i = F.tid; i < 9 * 256; i += 512) { const int b_ = i >> 8, q_ = i & 255; *(LAS f32x4*)(MC + b_ * 1024 + q_ * 4) = *(const GAS f32x4*)(mod_comb + (size_t)b_ * 6144 + q_ * 4); } }
    __syncthreads();
    if (ROUTER) { if (F.tid < 8) hist[F.tid] = 0; __syncthreads(); }
    f32x4 gv[4];
#pragma unroll
    for (int j = 0; j < 4; ++j) gv[j] = *(const GAS f32x4*)(gain + 4 * F.lane + 256 * j);
    float wr[16][8];
    if (ROUTER) {
#pragma unroll
        for (int j = 0; j < 4; ++j)
#pragma unroll
            for (int q = 0; q < 4; ++q) { const int c = 4 * F.lane + 256 * j + q; const f32x4 wa = *(const GAS f32x4*)(w_router + (size_t)c * 8), wb = *(const GAS f32x4*)(w_router + (size_t)c * 8 + 4);
                wr[j * 4 + q][0] = wa[0]; wr[j * 4 + q][1] = wa[1]; wr[j * 4 + q][2] = wa[2]; wr[j * 4 + q][3] = wa[3]; wr[j * 4 + q][4] = wb[0]; wr[j * 4 + q][5] = wb[1]; wr[j * 4 + q][6] = wb[2]; wr[j * 4 + q][7] = wb[3]; } }
#define LOADROW(r_, dst, dstb, tkd) do { if (SRC == 1) { const float* src_ = (r_) < NLAT ? P.in[I_X] + (size_t)(r_) * DM : P.in[I_CTX] + (size_t)((r_) - NLAT) * DM; \
            _Pragma("unroll") for (int j = 0; j < 4; ++j) dst[j] = __builtin_nontemporal_load((const GAS f32x4*)(src_ + 4 * F.lane + 256 * j)); } \
        else { _Pragma("unroll") for (int j = 0; j < 4; ++j) dstb[j] = *(const GAS u32x2*)(X + (size_t)(r_) * DM + 4 * F.lane + 256 * j); } \
        if (COMB) { if ((r_) < comb_rows) tkd = *(const GAS u32x4*)(TOK + (size_t)(r_) * 8 + 4); } } while (0)
#define XSTORE(row_, j_, val_) do { u32x2 xw_; xw_.x = pk2((val_)[0], (val_)[1]); xw_.y = pk2((val_)[2], (val_)[3]); *(GAS u32x2*)(X + (size_t)(row_) * DM + 4 * F.lane + 256 * (j_)) = xw_; } while (0)
    f32x4 vn[4]; u32x2 vnb[4]; u32x4 tkn = {0u, 0u, 0u, 0u};
    if (F.gw < nrows) LOADROW(F.gw, vn, vnb, tkn);
    for (int row = F.gw; row < nrows; row += F.NGW) {
        const int bidx = row < NLAT ? (row >> 12) : NB;
        f32x4 v[4]; const u32x4 tkc = tkn;
#pragma unroll
        for (int j = 0; j < 4; ++j) { if (SRC == 1) v[j] = vn[j]; else v[j] = (f32x4){__builtin_bit_cast(float, vnb[j].x << 16), __builtin_bit_cast(float, vnb[j].x & 0xffff0000u), __builtin_bit_cast(float, vnb[j].y << 16), __builtin_bit_cast(float, vnb[j].y & 0xffff0000u)}; }
        u32x2 ya[4], yb[4]; float w0 = 0.f, w1 = 0.f;
        if (COMB) { if (row < comb_rows) { const int* tk = TOK + (size_t)row * 8; w0 = __int_as_float(tk[2]); w1 = __int_as_float(tk[3]); const int s0 = (int)tkc[2], s1 = (int)tkc[3];
#pragma unroll
            for (int j = 0; j < 4; ++j) { ya[j] = *(const GAS u32x2*)(Y + (size_t)s0 * DM + 4 * F.lane + 256 * j); yb[j] = *(const GAS u32x2*)(Y + (size_t)s1 * DM + 4 * F.lane + 256 * j); } } }
        { const int nrow = row + F.NGW; if (nrow < nrows) LOADROW(nrow, vn, vnb, tkn); }
        if (SLABS) { if (slabS > 1) { const int pm_ = row >> 8; bool any_ = false;
#pragma unroll
            for (int j = 0; j < 4; ++j) { const int tu_ = tailmap[pm_ * 4 + j]; if (tu_) { any_ = true; for (int s_ = 0; s_ < slabS; ++s_) { const u32x2 t_ = *(const GAS u32x2*)((const bf16_t*)SLAB + ((size_t)(s_ * slabT + tu_ - 1) * 256 + (row & 255)) * 256 + 4 * F.lane);
                    v[j] = v[j] + (f32x4){__builtin_bit_cast(float, t_.x << 16), __builtin_bit_cast(float, t_.x & 0xffff0000u), __builtin_bit_cast(float, t_.y << 16), __builtin_bit_cast(float, t_.y & 0xffff0000u)}; } } }
            if (any_) {
#pragma unroll
                for (int j = 0; j < 4; ++j) XSTORE(row, j, v[j]); } } }
        if (SRC == 1) {
#pragma unroll
            for (int j = 0; j < 4; ++j) XSTORE(row, j, v[j]); }
        if (COMB) { if (row < comb_rows) { const int s0 = (int)tkc[2], s1 = (int)tkc[3];
#pragma unroll
            for (int j = 0; j < 4; ++j) { const u32x2 a = ya[j], b = yb[j];
                const f32x4 g5 = *(const LAS f32x4*)(MC + bidx * 1024 + 4 * F.lane + 256 * j);
                f32x4 ya4 = {bf2f(a.x & 0xffff), bf2f(a.x >> 16), bf2f(a.y & 0xffff), bf2f(a.y >> 16)}, yb4 = {bf2f(b.x & 0xffff), bf2f(b.x >> 16), bf2f(b.y & 0xffff), bf2f(b.y >> 16)};
                if (mS > 1) { const int ta = tailmap[(s0 >> 8) * 4 + j], tb = tailmap[(s1 >> 8) * 4 + j];
                    if (ta) { ya4 = (f32x4){0.f, 0.f, 0.f, 0.f}; for (int s_ = 0; s_ < mS; ++s_) ya4 = ya4 + *(const GAS f32x4*)(SLAB2 + ((size_t)(s_ * mT + ta - 1) * 256 + (s0 & 255)) * 256 + 4 * F.lane); }
                    if (tb) { yb4 = (f32x4){0.f, 0.f, 0.f, 0.f}; for (int s_ = 0; s_ < mS; ++s_) yb4 = yb4 + *(const GAS f32x4*)(SLAB2 + ((size_t)(s_ * mT + tb - 1) * 256 + (s1 & 255)) * 256 + 4 * F.lane); } }
                f32x4 y = ya4 * w0 + yb4 * w1;
                v[j] = v[j] + g5 * y; if (OUT != 2) XSTORE(row, j, v[j]); } } }
        if (OUT == 2 && row >= NLAT) continue;
        float s = 0.f;
#pragma unroll
        for (int j = 0; j < 4; ++j) s += (v[j][0] * v[j][0] + v[j][1] * v[j][1]) + (v[j][2] * v[j][2] + v[j][3] * v[j][3]);
        const float rstd = rsqrtf(wave_sum_dpp(s) * (1.0f / DM) + EPS);
        if (OUT == 2) {
#pragma unroll
            for (int j = 0; j < 4; ++j) __builtin_nontemporal_store(v[j] * rstd * gv[j], (GAS f32x4*)(P.out + (size_t)row * DM + 4 * F.lane + 256 * j));
            continue; }
        f32x4 hh[4];
#pragma unroll
        for (int j = 0; j < 4; ++j) { const f32x4 sh = *(const LAS f32x4*)(MS + bidx * 2048 + 4 * F.lane + 256 * j), sc = *(const LAS f32x4*)(MS + bidx * 2048 + 1024 + 4 * F.lane + 256 * j);
            hh[j] = (v[j] * rstd * gv[j]) * (sc + 1.0f) + sh; }
#pragma unroll
        for (int j = 0; j < 4; ++j) { u32x2 w; w.x = pk2(hh[j][0], hh[j][1]); w.y = pk2(hh[j][2], hh[j][3]);
            if (OUT == 0) *(GAS u32x2*)(H + (size_t)row * DM + 4 * F.lane + 256 * j) = w;
            else { const int grp = (F.lane >> 2) + 16 * j; *(GAS u32x2*)(H + ((size_t)grp * MT + row) * 16 + 4 * (F.lane & 3)) = w; } }
        if (ROUTER) { if (row < route_rows) {
            float pl[8];
#pragma unroll
            for (int e = 0; e < 8; ++e) pl[e] = 0.f;
#pragma unroll
            for (int j = 0; j < 4; ++j)
#pragma unroll
                for (int q = 0; q < 4; ++q) { const float hv = hh[j][q];
#pragma unroll
                    for (int e = 0; e < 8; ++e) pl[e] += hv * wr[j * 4 + q][e]; }
            float lg[8];
            { const bool b2 = (F.lane & 4) != 0, b1 = (F.lane & 2) != 0, b0 = (F.lane & 1) != 0; float q4[4], r2[2];
#pragma unroll
              for (int i = 0; i < 4; ++i) { const float keep = b2 ? pl[4 + i] : pl[i], send = b2 ? pl[i] : pl[4 + i]; q4[i] = keep + __shfl_xor(send, 4); }
#pragma unroll
              for (int i = 0; i < 2; ++i) { const float keep = b1 ? q4[2 + i] : q4[i], send = b1 ? q4[i] : q4[2 + i]; r2[i] = keep + __shfl_xor(send, 2); }
              float tot = (b0 ? r2[1] : r2[0]) + __shfl_xor(b0 ? r2[0] : r2[1], 1);
              tot += __shfl_xor(tot, 8); tot += __shfl_xor(tot, 16); tot += __shfl_xor(tot, 32);
#pragma unroll
              for (int e = 0; e < 8; ++e) lg[e] = __builtin_bit_cast(float, __builtin_amdgcn_readlane(__builtin_bit_cast(int, tot), e)) + b_router[e]; }
            int e0 = 0; float v0 = lg[0];
#pragma unroll
            for (int e = 1; e < 8; ++e) if (lg[e] > v0) { v0 = lg[e]; e0 = e; }
            int e1 = -1; float v1 = -3.0e38f;
#pragma unroll
            for (int e = 0; e < 8; ++e) if (e != e0 && lg[e] > v1) { v1 = lg[e]; e1 = e; }
            const float ex = __expf(v1 - v0); const float w0 = __builtin_amdgcn_rcpf(1.0f + ex), w1 = ex * w0;
            if (F.lane == 0) { const int l0 = __hip_atomic_fetch_add(hist + e0, 1, __ATOMIC_RELAXED, __HIP_MEMORY_SCOPE_WORKGROUP), l1 = __hip_atomic_fetch_add(hist + e1, 1, __ATOMIC_RELAXED, __HIP_MEMORY_SCOPE_WORKGROUP);
                int* tk = TOK + (size_t)row * 8; tk[0] = e0; tk[1] = e1; tk[2] = __float_as_int(w0); tk[3] = __float_as_int(w1); tk[4] = l0; tk[5] = l1; } } }
    }
#undef LOADROW
#undef XSTORE
    if (ROUTER) { __syncthreads(); if (F.tid < 8) ((int*)(F.ws + WS_BLKCNT))[F.blk * 8 + F.tid] = hist[F.tid]; __syncthreads(); }
}

__device__ __forceinline__ void phase_scatter(const Frame& F0, int nrows) {
    const Frame F = refresh(F0);
    const int* BC = (const int*)(F.ws + WS_BLKCNT); int* TOK = (int*)(F.ws + WS_TOK); int* TILEE = (int*)(F.ws + WS_TILEE);
    LAS int* sh = (LAS int*)(F.lds);
    for (int i = F.tid; i < F.G * 8; i += 512) sh[64 + i] = BC[i];
    __syncthreads();
    if (F.tid < 8) { sh[32 + F.tid] = 0; sh[F.tid] = 0; }
    __syncthreads();
    for (int i = F.tid; i < F.G * 8; i += 512) { const int c = sh[64 + i], e = i & 7, b = i >> 3; if (c) { __hip_atomic_fetch_add(sh + 32 + e, c, __ATOMIC_RELAXED, __HIP_MEMORY_SCOPE_WORKGROUP); if (b < F.blk) __hip_atomic_fetch_add(sh + e, c, __ATOMIC_RELAXED, __HIP_MEMORY_SCOPE_WORKGROUP); } }
    __syncthreads();
    if (F.tid == 0) { int off = 0; for (int e = 0; e < 8; ++e) { sh[8 + e] = off; off += ((sh[32 + e] + 255) >> 8) << 8; } sh[16] = off; }
    __syncthreads();
    if (F.blk == 0) { const int ntm = sh[16] >> 8; for (int t = F.tid; t < 511; t += 512) { int e = 7; for (int q = 0; q < 8; ++q) if (t * 256 >= sh[8 + q] && t * 256 < sh[9 + q]) e = q; TILEE[t] = e; } if (F.tid == 0) TILEE[511] = ntm; }
    int* S2R = (int*)(F.ws + WS_S2R);
    if (F.blk == 1 % F.G) { for (int e = 0; e < 8; ++e) { const int lo = sh[8 + e] + sh[32 + e], hi = sh[9 + e]; for (int s = lo + F.tid; s < hi; s += 512) S2R[s] = 0; } }
    { const int row = F.gw + F.lane * F.NGW;
      if (F.lane * F.NGW + F.gw < nrows) { int* tk = TOK + (size_t)row * 8; const u32x4 t0 = *(const u32x4*)tk, t1 = *(const GAS u32x4*)(tk + 4); const int e0 = (int)t0[0], e1 = (int)t0[1];
          const int s0 = sh[8 + e0] + sh[e0] + (int)t1[0], s1 = sh[8 + e1] + sh[e1] + (int)t1[1]; tk[6] = s0; tk[7] = s1; S2R[s0] = row; S2R[s1] = row; } }
    __syncthreads();
}

__device__ __forceinline__ void phase_pool(const Frame& F0) {
    const Frame F = refresh(F0);
    const bf16_t* H = (const bf16_t*)(F.ws + WS_H); bf16_t* PIN = (bf16_t*)(F.ws + WS_BIG);
    LAS unsigned char* tile = F.lds;
    u32x4 nx[12];
#define POOL_GEOM(tl_, r0_, base_, L_, t0_) const int r0_ = (tl_) * 32; int base_, L_; if (r0_ < NLAT) { base_ = r0_ & ~(SEQ - 1); L_ = SEQ; } else { base_ = NLAT + ((r0_ - NLAT) & ~(CTX - 1)); L_ = CTX; } const int t0_ = r0_ - base_
#define POOL_LOAD(tl_) do { POOL_GEOM(tl_, r0n, basen, Ln, t0n); _Pragma("unroll") for (int k = 0; k < 12; ++k) { const int i = F.tid + 512 * k, lr = i >> 7, c = i & 127, t = t0n - 8 + lr; \
            if (t >= 0 && t < Ln) nx[k] = *(const GAS u32x4*)(H + (size_t)(basen + t) * DM + c * 8); } } while (0)
    if (F.blk < MT / 32) POOL_LOAD(F.blk);
    for (int tl = F.blk; tl < MT / 32; tl += F.G) {
        POOL_GEOM(tl, r0, base, L, t0);
        __syncthreads();
#pragma unroll
        for (int k = 0; k < 12; ++k) { const int i = F.tid + 512 * k, lr = i >> 7, c = i & 127, t = t0 - 8 + lr; if (t >= 0 && t < L) *(LAS u32x4*)(tile + lr * 2048 + c * 16) = nx[k]; }
        __syncthreads();
        if (tl + F.G < MT / 32) POOL_LOAD(tl + F.G);
        { const int c8 = F.tid & 127, rq = F.tid >> 7, w = 2 << (c8 >> 5), hw = w >> 1;
#pragma unroll 2
          for (int rr = 0; rr < 8; ++rr) { const int lr = rq * 8 + rr, t = t0 + lr;
              int lo = t - hw; if (lo < 0) lo = 0; int hi = t + w - hw; if (hi > L) hi = L;
              float s[8];
#pragma unroll
              for (int q = 0; q < 8; ++q) s[q] = 0.f;
              for (int r = lo; r < hi; ++r) { const u32x4 a = *(const LAS u32x4*)(tile + (r - t0 + 8) * 2048 + c8 * 16);
                  s[0] += bf2f(a.x & 0xffff); s[1] += bf2f(a.x >> 16); s[2] += bf2f(a.y & 0xffff); s[3] += bf2f(a.y >> 16); s[4] += bf2f(a.z & 0xffff); s[5] += bf2f(a.z >> 16); s[6] += bf2f(a.w & 0xffff); s[7] += bf2f(a.w >> 16); }
              const float inv = __builtin_amdgcn_rcpf((float)(hi - lo));
              const u32x4 a = *(const LAS u32x4*)(tile + (lr + 8) * 2048 + c8 * 16);
              u32x4 o; o.x = pk2(s[0] * inv - bf2f(a.x & 0xffff), s[1] * inv - bf2f(a.x >> 16)); o.y = pk2(s[2] * inv - bf2f(a.y & 0xffff), s[3] * inv - bf2f(a.y >> 16));
              o.z = pk2(s[4] * inv - bf2f(a.z & 0xffff), s[5] * inv - bf2f(a.z >> 16)); o.w = pk2(s[6] * inv - bf2f(a.w & 0xffff), s[7] * inv - bf2f(a.w >> 16));
              *(GAS u32x4*)(PIN + (size_t)(r0 + lr) * DM + c8 * 8) = o; } }
    }
#undef POOL_GEOM
#undef POOL_LOAD
    __syncthreads();
}

__device__ __forceinline__ void phase_krope(const Frame& F0, int nrows) {
    const Frame F = refresh(F0);
    const bf16_t* Z = (const bf16_t*)(F.ws + WS_BIG + B_Z); bf16_t* KR = (bf16_t*)(F.ws + WS_BIG + B_KR); const f32x2* RT = (const f32x2*)(F.ws + WS_ROPE);
    for (int it = F.blk * 512 + F.tid; it < nrows * 4; it += F.G * 512) { const int row = it >> 2, part = it & 3;
        const u32x4 a = *(const GAS u32x4*)(Z + (size_t)row * ZW + 640 + part * 8);
        float v[8] = {bf2f(a.x & 0xffff), bf2f(a.x >> 16), bf2f(a.y & 0xffff), bf2f(a.y >> 16), bf2f(a.z & 0xffff), bf2f(a.z >> 16), bf2f(a.w & 0xffff), bf2f(a.w >> 16)};
        if (row < NLAT) { const f32x4* cs = (const f32x4*)(RT + (size_t)(row & (SEQ - 1)) * 16 + part * 4); const f32x4 c01 = cs[0], c23 = cs[1]; float x1, x2;
            x1 = v[0]; x2 = v[1]; v[0] = x1 * c01[0] - x2 * c01[1]; v[1] = x2 * c01[0] + x1 * c01[1];
            x1 = v[2]; x2 = v[3]; v[2] = x1 * c01[2] - x2 * c01[3]; v[3] = x2 * c01[2] + x1 * c01[3];
            x1 = v[4]; x2 = v[5]; v[4] = x1 * c23[0] - x2 * c23[1]; v[5] = x2 * c23[0] + x1 * c23[1];
            x1 = v[6]; x2 = v[7]; v[6] = x1 * c23[2] - x2 * c23[3]; v[7] = x2 * c23[2] + x1 * c23[3]; }
        u32x4 w; w.x = pk2(v[0], v[1]); w.y = pk2(v[2], v[3]); w.z = pk2(v[4], v[5]); w.w = pk2(v[6], v[7]);
        *(GAS u32x4*)(KR + (size_t)row * 32 + part * 8) = w;
    }
}

struct TJob { const float* W; int K, N; bf16_t* WT; int NR, map; const float* ks; };
__device__ __forceinline__ int rope_orig(int d) { return (d & 16) + ((d & 1) << 3) + ((d & 15) >> 1); }
__device__ __forceinline__ int tjob_srccol(const TJob& J, int n) {
    switch (J.map) {
        case 1: { const int pn = n >> 8, r = n & 255; return r < 128 ? 128 * pn + r : (J.N >> 1) + 128 * pn + (r - 128); }
        case 2: return n < 256 ? n : (n < 288 ? 256 + rope_orig(n - 256) : -1);
        case 3: { const int h = n / QKD, d = n % QKD; return d < 64 ? n : h * QKD + 64 + rope_orig(d - 64); }
        default: return n;
    }
}
constexpr int N_TJOBS = 51;
__device__ __forceinline__ TJob get_tjob(int j, const Params& P, unsigned char* ws) {
    TJob J; J.ks = nullptr; J.map = 0; unsigned char* wb = ws + WS_W;
    if (j < 8) { const int l = j >> 2, kind = j & 3; unsigned char* m = wb + WO_MLA + (size_t)l * W_MLA_SZ;
        if (kind == 0) { J.W = P.in[I_WDQ] + (size_t)l * DM * QLORA; J.K = DM; J.N = QLORA; J.WT = (bf16_t*)(m + W_DQKV); J.NR = QLORA; }
        else if (kind == 1) { J.W = P.in[I_WDKV] + (size_t)l * DM * 288; J.K = DM; J.N = 288; J.WT = (bf16_t*)(m + W_DQKV) + (size_t)QLORA * DM; J.NR = 384; J.map = 2; }
        else if (kind == 2) { J.W = P.in[I_WUQ] + (size_t)l * QLORA * 1536; J.K = QLORA; J.N = 1536; J.WT = (bf16_t*)(m + W_UQ); J.NR = 1536; J.map = 3; J.ks = P.in[I_QNORM] + l * QLORA; }
        else { J.W = P.in[I_WUKV] + (size_t)l * KVLORA * 2048; J.K = KVLORA; J.N = 2048; J.WT = (bf16_t*)(m + W_UKV); J.NR = 2048; J.ks = P.in[I_KVNORM] + l * KVLORA; }
    } else if (j < 10) { const int l = j - 8; J.W = P.in[I_WO] + (size_t)l * DM * DM; J.K = DM; J.N = DM; J.WT = (bf16_t*)(wb + WO_MLA + (size_t)l * W_MLA_SZ + W_O); J.NR = DM; }
    else if (j < 14) { const int k = (j - 10) >> 1, dn = (j - 10) & 1; unsigned char* m = wb + WO_FFN + (size_t)k * W_FFN_SZ;
        if (!dn) { J.W = P.in[I_FGU] + (size_t)k * DM * 2 * FFN; J.K = DM; J.N = 2 * FFN; J.WT = (bf16_t*)m; J.NR = 2 * FFN; J.map = 1; }
        else { J.W = P.in[I_FDN] + (size_t)k * FFN * DM; J.K = FFN; J.N = DM; J.WT = (bf16_t*)(m + W_GU_SZ); J.NR = DM; } }
    else if (j < 46) { const int ke = (j - 14) >> 1, dn = (j - 14) & 1; unsigned char* m = wb + WO_MOE + (size_t)ke * W_FFN_SZ;
        if (!dn) { J.W = P.in[I_MGU] + (size_t)ke * DM * 2 * FFN; J.K = DM; J.N = 2 * FFN; J.WT = (bf16_t*)m; J.NR = 2 * FFN; J.map = 1; }
        else { J.W = P.in[I_MDN] + (size_t)ke * FFN * DM; J.K = FFN; J.N = DM; J.WT = (bf16_t*)(m + W_GU_SZ); J.NR = DM; } }
    else if (j == 46) { J.W = P.in[I_S5GLU]; J.K = DM; J.N = 2048; J.WT = (bf16_t*)(wb + WO_GLU); J.NR = 2048; J.map = 1; }
    else { const int g = j - 47; J.W = P.in[I_POOLW] + (size_t)g * 65536; J.K = 256; J.N = 256; J.WT = (bf16_t*)(wb + WO_POOL + (size_t)g * 131072); J.NR = 256; }
    return J;
}
__device__ __forceinline__ void transpose_item(const TJob& J, LAS float* scr, int item, int lane) {
    const int nblk = J.NR / 32, kb = item / nblk, nb = item % nblk, k0 = 64 * kb, n0 = 32 * nb;
    const int sc = tjob_srccol(J, n0 + (lane & 31));
#pragma unroll 8
    for (int i = 0; i < 32; ++i) { const int kk = 2 * i + (lane >> 5); float v = sc >= 0 ? J.W[(size_t)(k0 + kk) * J.N + sc] : 0.f; if (J.ks) v *= J.ks[k0 + kk]; scr[kk * 33 + (lane & 31)] = v; }
    asm volatile("s_waitcnt lgkmcnt(0)" ::: "memory");
    const int c = lane & 7;
#pragma unroll
    for (int jj = 0; jj < 4; ++jj) { const int n = (lane >> 3) + 8 * jj; const LAS float* s = scr + (8 * c) * 33 + n;
        u32x4 o; o.x = pk2(s[0 * 33], s[1 * 33]); o.y = pk2(s[2 * 33], s[3 * 33]); o.z = pk2(s[4 * 33], s[5 * 33]); o.w = pk2(s[6 * 33], s[7 * 33]);
        *(GAS u32x4*)(J.WT + (size_t)(n0 + n) * J.K + k0 + 8 * c) = o; }
    asm volatile("s_waitcnt lgkmcnt(0)" ::: "memory");
}
struct TLoad { f32x4 v[16]; };
__device__ __forceinline__ void tfast_load(const TJob& J, int item, int lane, TLoad& L) {
    const int nblk = J.NR / 64, kb = item / nblk, nb = item % nblk, k0 = 64 * kb, n0 = 64 * nb;
    const int sc = tjob_srccol(J, n0) + 4 * (lane & 15);
    const float* src = J.W + (size_t)(k0 + (lane >> 4)) * J.N + sc;
#pragma unroll
    for (int i = 0; i < 16; ++i) L.v[i] = __builtin_nontemporal_load((const GAS f32x4*)(src + (size_t)(4 * i) * J.N));
}
__device__ __forceinline__ void tfast_store(const TJob& J, int item, int lane, const TLoad& L, LAS unsigned char* tile) {
    const int nblk = J.NR / 64, kb = item / nblk, nb = item % nblk, k0 = 64 * kb, n0 = 64 * nb;
#pragma unroll
    for (int i = 0; i < 16; ++i) { const int kr = 4 * i + (lane >> 4); f32x4 v = L.v[i]; if (J.ks) v = v * J.ks[k0 + kr];
        u32x2 w; w.x = cvt_pk_bf16(v[0], v[1]); w.y = cvt_pk_bf16(v[2], v[3]); *(LAS u32x2*)(tile + kr * 192 + 8 * (lane & 15)) = w; }
    asm volatile("s_waitcnt lgkmcnt(0)" ::: "memory");
    const int g = lane >> 4, i16 = lane & 15, q = (lane >> 2) & 3, p = lane & 3;
#pragma unroll
    for (int nbk = 0; nbk < 4; ++nbk)
#pragma unroll
        for (int half = 0; half < 2; ++half) { const int c = 4 * half + g;
            const unsigned a0 = (unsigned)(uintptr_t)(tile + (8 * c + q) * 192 + (16 * nbk + 4 * p) * 2);
            s16x4 lo, hi; asm volatile("ds_read_b64_tr_b16 %0, %1" : "=&v"(lo) : "v"(a0) : "memory"); asm volatile("ds_read_b64_tr_b16 %0, %1 offset:768" : "=&v"(hi) : "v"(a0) : "memory");
            asm volatile("s_waitcnt lgkmcnt(0)" : "+v"(lo), "+v"(hi) :: "memory");
            const bf16x8 o = (bf16x8){lo[0], lo[1], lo[2], lo[3], hi[0], hi[1], hi[2], hi[3]};
            *(GAS bf16x8*)(J.WT + (size_t)(n0 + 16 * nbk + i16) * J.K + k0 + 8 * c) = o; }
    asm volatile("s_waitcnt lgkmcnt(0)" ::: "memory");
}
__device__ __forceinline__ void adaln_task(const Params& P, float* MOD, const LAS float* ST, int task, int lane) {
    const int cbk = task % 192, l = task / 192, kq = lane >> 3, cq = lane & 7;
    const int col = cbk * 32 + 4 * cq, k0 = kq * 128;
    const float* W = P.in[I_ADAW] + (size_t)l * DM * 6144 + col;
    f32x4 acc[9];
#pragma unroll
    for (int r = 0; r < 9; ++r) acc[r] = (f32x4){0.f, 0.f, 0.f, 0.f};
#pragma unroll 8
    for (int kk = 0; kk < 128; ++kk) { const int k = k0 + kk; const f32x4 w = *(const GAS f32x4*)(W + (size_t)k * 6144);
#pragma unroll
        for (int r = 0; r < 9; ++r) acc[r] = acc[r] + w * ST[r * 1024 + k]; }
    const f32x4 b = *(const GAS f32x4*)(P.in[I_ADAB] + (size_t)l * 6144 + col);
#pragma unroll
    for (int r = 0; r < 9; ++r) { f32x4 v = acc[r];
#pragma unroll
        for (int q = 0; q < 4; ++q) { float x = v[q]; x += __shfl_xor(x, 8); x += __shfl_xor(x, 16); x += __shfl_xor(x, 32); v[q] = x; }
        if (kq == 0) *(GAS f32x4*)(MOD + ((size_t)l * 9 + r) * 6144 + col) = v + b; }
}
__device__ __forceinline__ void s5_precompute(const Frame& F, const Params& P, int g) {
    LAS float* LP = (LAS float*)F.lds;
    LAS float* BB = LP + 2 * 9 * 64 * 2;
    LAS float* CC = BB + 2 * 64 * 16 * 2;
    LAS float* KT = CC + 2 * 16 * 64 * 2;
    __syncthreads();
    if (F.tid < 128) { const int dir = F.tid >> 6, p = F.tid & 63; const int ix = (dir * 64 + g) * 64 + p;
        const float are = fminf(P.in[I_S5ARE][ix], -1e-4f), aim = P.in[I_S5AIM][ix], dt = expf(P.in[I_S5LDT][dir * 64 + g]);
        const float lr = are * dt, li = aim * dt, mag = expf(lr), br = mag * cosf(li), bi = mag * sinf(li);
        float pr = 1.f, pi = 0.f;
        for (int k = 0; k <= 8; ++k) { LP[((dir * 9 + k) * 64 + p) * 2] = pr; LP[((dir * 9 + k) * 64 + p) * 2 + 1] = pi; const float nr = pr * br - pi * bi, ni = pr * bi + pi * br; pr = nr; pi = ni; }
        const float xr = br - 1.f, xi = bi, den = are * are + aim * aim; const float cr = (xr * are + xi * aim) / den, ci = (xi * are - xr * aim) / den;
        for (int n = 0; n < 16; ++n) { const float b_r = P.in[I_S5BRE][(size_t)ix * 16 + n], b_i = P.in[I_S5BIM][(size_t)ix * 16 + n];
            BB[((dir * 64 + p) * 16 + n) * 2] = cr * b_r - ci * b_i; BB[((dir * 64 + p) * 16 + n) * 2 + 1] = cr * b_i + ci * b_r; }
        for (int n = 0; n < 16; ++n) { const size_t cx = ((size_t)(dir * 64 + g) * 16 + n) * 64 + p; CC[((dir * 16 + n) * 64 + p) * 2] = P.in[I_S5CRE][cx]; CC[((dir * 16 + n) * 64 + p) * 2 + 1] = P.in[I_S5CIM][cx]; }
        float* L8 = (float*)(F.ws + WS_S5L8) + ((size_t)(g * 2 + dir) * 64 + p) * 2; L8[0] = LP[((dir * 9 + 8) * 64 + p) * 2]; L8[1] = LP[((dir * 9 + 8) * 64 + p) * 2 + 1]; }
    __syncthreads();
    for (int i = F.tid; i < 2 * 8 * 256; i += 512) { const int dir = i >> 11, tau = (i >> 8) & 7, n = (i >> 4) & 15, m = i & 15; float s = 0.f;
        for (int p = 0; p < 64; ++p) { const float c_r = CC[((dir * 16 + n) * 64 + p) * 2], c_i = CC[((dir * 16 + n) * 64 + p) * 2 + 1], l_r = LP[((dir * 9 + tau) * 64 + p) * 2], l_i = LP[((dir * 9 + tau) * 64 + p) * 2 + 1];
            const float w_r = c_r * l_r - c_i * l_i, w_i = c_r * l_i + c_i * l_r; const float b_r = BB[((dir * 64 + p) * 16 + m) * 2], b_i = BB[((dir * 64 + p) * 16 + m) * 2 + 1];
            s += w_r * b_r - w_i * b_i; }
        KT[i] = s; }
    __syncthreads();
    bf16_t* FBg = (bf16_t*)(F.ws + WS_S5FB) + (size_t)g * 2 * 32 * 512; bf16_t* EBg = (bf16_t*)(F.ws + WS_S5EB) + (size_t)g * 2 * 32 * 512; bf16_t* MBg = (bf16_t*)(F.ws + WS_S5MB) + (size_t)g * 32 * 512;
    const float* Dv = P.in[I_S5D] + g * 16;
    for (int i = F.tid; i < 2 * 32 * 512; i += 512) { const int j = i & 7, lane = (i >> 3) & 63, frag = (i >> 9) & 31, dir = i >> 14; const int h = lane >> 5, col = lane & 31;
        {
            const int s = frag >> 2, jn = frag & 3, p = (jn >> 1) * 32 + col, c = jn & 1, m = 8 * h + j, pw = dir == 0 ? 7 - s : s;
            const float l_r = LP[((dir * 9 + pw) * 64 + p) * 2], l_i = LP[((dir * 9 + pw) * 64 + p) * 2 + 1], b_r = BB[((dir * 64 + p) * 16 + m) * 2], b_i = BB[((dir * 64 + p) * 16 + m) * 2 + 1];
            FBg[i] = (bf16_t)f2bf(c == 0 ? l_r * b_r - l_i * b_i : l_r * b_i + l_i * b_r); }
        {
            const int ks = frag >> 2, jn = frag & 3, t = 2 * jn + (col >> 4), n = col & 15, k = 16 * ks + 8 * h + j, p = k >> 1, c = k & 1, pw = dir == 0 ? t + 1 : 8 - t;
            const float c_r = CC[((dir * 16 + n) * 64 + p) * 2], c_i = CC[((dir * 16 + n) * 64 + p) * 2 + 1], l_r = LP[((dir * 9 + pw) * 64 + p) * 2], l_i = LP[((dir * 9 + pw) * 64 + p) * 2 + 1];
            EBg[i] = (bf16_t)f2bf(c == 0 ? c_r * l_r - c_i * l_i : -(c_r * l_i + c_i * l_r)); } }
    for (int i = F.tid; i < 32 * 512; i += 512) { const int j = i & 7, lane = (i >> 3) & 63, frag = i >> 9; const int h = lane >> 5, col = lane & 31;
        const int s = frag >> 2, jn = frag & 3, t = 2 * jn + (col >> 4), n = col & 15, m = 8 * h + j; float v = 0.f;
        if (t >= s) v += KT[((0 * 8 + (t - s)) * 16 + n) * 16 + m];
        if (s >= t) v += KT[((1 * 8 + (s - t)) * 16 + n) * 16 + m];
        if (t == s && n == m) v += Dv[n];
        MBg[i] = (bf16_t)f2bf(v); }
    __syncthreads();
}
constexpr int BG_GLU = 512, BG_PER_E = 2112, BG_K0_END = BG_GLU + 8 * BG_PER_E, BG_TOTAL = BG_GLU + 16 * BG_PER_E;
constexpr int BG_R12_LO = BG_GLU, BG_R12_HI = BG_GLU + 2000;
constexpr int BG_R16_LO = BG_K0_END, BG_R16_HI = BG_K0_END + 6000;
constexpr int BG_S5A_LO = BG_R16_HI, BG_S5A_HI = BG_R16_HI + 7000;
__device__ __forceinline__ void bg_items(const Params& P, unsigned char* ws, int lo, int hi, int sw, int NSW, int lane, LAS unsigned char* tile) {
    TLoad La, Lb;
#define BG_JOB(g_, J_, it_) do { int j_, r_; if ((g_) < BG_GLU) { j_ = 46; r_ = (g_); } else { const int q_ = (g_) - BG_GLU, ke_ = q_ / BG_PER_E, rr_ = q_ % BG_PER_E; if (rr_ < 1408) { j_ = 14 + 2 * ke_; r_ = rr_; } else { j_ = 15 + 2 * ke_; r_ = rr_ - 1408; } } \
        J_ = get_tjob(j_, P, ws); it_ = r_; } while (0)
    int g = lo + sw; TJob Ja, Jb; int ia = 0, ib = 0;
    if (g < hi) { BG_JOB(g, Ja, ia); tfast_load(Ja, ia, lane, La); }
    for (; g < hi; g += 2 * NSW) {
        const int g1 = g + NSW, g2 = g + 2 * NSW;
        if (g1 < hi) { BG_JOB(g1, Jb, ib); tfast_load(Jb, ib, lane, Lb); }
        tfast_store(Ja, ia, lane, La, tile);
        if (g1 < hi) { const TJob Jc = Jb; const int ic = ib; if (g2 < hi) { BG_JOB(g2, Ja, ia); tfast_load(Ja, ia, lane, La); } tfast_store(Jc, ic, lane, Lb, tile); }
    }
#undef BG_JOB
}
__device__ __forceinline__ void bg_convert(const Frame& F0, const Params& P, int lo, int hi, int c, int short_c0) {
    if (c < short_c0 || lo >= hi) return;
    const Frame F = refresh(F0);
    __syncthreads();
    bg_items(P, F.ws, lo, hi, (c - short_c0) * 8 + F.wave, (F.G - short_c0) * 8, F.lane, F.lds + F.wave * 12288);
    __syncthreads();
}
__device__ __forceinline__ void phase_p0(const Frame& F0, const Params& P) {
    const Frame F = refresh(F0);
    const bool bg = (F.G == 256);
    for (int g = F.blk; g < 64; g += F.G) s5_precompute(F, P, g);
    { f32x2* RT = (f32x2*)(F.ws + WS_ROPE);
      for (int i = F.blk * 512 + F.tid; i < SEQ * 16; i += F.G * 512) { const int t = i >> 4, a = (i >> 3) & 1, f = i & 7; const float pos = (float)(a == 0 ? (t >> 6) : (t & 63));
          const float inv = 1.0f / powf(10000.0f, (float)f / 8.0f); const float ang = pos * inv; RT[i] = (f32x2){cosf(ang), sinf(ang)}; } }
    float* MOD = (float*)(F.ws + CTL_MOD);
    int base = 0;
    { LAS float* ST = (LAS float*)(F.lds + 98304);
      for (int i = F.tid; i < 9 * 1024; i += 512) { const float cv = i < 8192 ? P.in[I_C][i] : P.in[I_CCTX][i - 8192]; ST[i] = siluf_(cv); }
      __syncthreads();
      if ((F.gw & 1) == 0) { for (int it = F.gw >> 1; it < 4 * 192; it += (F.NGW + 1) >> 1) adaln_task(P, MOD, ST, it, F.lane); } }
    LAS float* scr = (LAS float*)(F.lds + F.wave * 12288);
    LAS unsigned char* tile = F.lds + F.wave * 12288;
    for (int j = 0; j < N_TJOBS; ++j) { if (bg && j >= 14 && j <= 46) continue;
        const TJob J = get_tjob(j, P, F.ws);
        const bool fast = (J.map == 0 || J.map == 1) && (J.NR % 64 == 0);
        const int n = fast ? (J.K / 64) * (J.NR / 64) : (J.K / 64) * (J.NR / 32);
        int first = (F.gw - base) % F.NGW; if (first < 0) first += F.NGW;
        if (fast) { TLoad La, Lb;
            if (first < n) tfast_load(J, first, F.lane, La);
            for (int it = first; it < n; it += 2 * F.NGW) {
                if (it + F.NGW < n) tfast_load(J, it + F.NGW, F.lane, Lb);
                tfast_store(J, it, F.lane, La, tile);
                if (it + F.NGW < n) { if (it + 2 * F.NGW < n) tfast_load(J, it + 2 * F.NGW, F.lane, La); tfast_store(J, it + F.NGW, F.lane, Lb, tile); } } }
        else for (int it = first; it < n; it += F.NGW) transpose_item(J, scr, it, F.lane);
        base += n; }
    if (bg) { bg_convert(F, P, 0, BG_R12_LO, F.blk, 0); bg_convert(F, P, BG_R12_HI, BG_R16_LO, F.blk, 0); bg_convert(F, P, BG_S5A_HI, BG_TOTAL, F.blk, 64); }
}

__device__ __forceinline__ void s5_chunk_rows(int dir, int b, int Ppos, int& row0) {
    int cn; bool ctx;
    if (dir == 0) { ctx = Ppos < 32; cn = ctx ? Ppos : Ppos - 32; } else { ctx = Ppos < 32; cn = ctx ? 31 - Ppos : 543 - Ppos; }
    row0 = ctx ? NLAT + b * CTX + cn * 8 : b * SEQ + cn * 8;
}
__device__ __forceinline__ void s5_mfma_stage(f32x16 (&acc)[4], const bf16x8 (&a)[8], const LAS unsigned char* fb, int lane) {
    bf16x8 f[2][4];
#pragma unroll
    for (int jn = 0; jn < 4; ++jn) f[0][jn] = *(const LAS bf16x8*)(fb + (jn * 64 + lane) * 16);
#pragma unroll
    for (int s = 0; s < 8; ++s) {
        if (s < 7) {
#pragma unroll
            for (int jn = 0; jn < 4; ++jn) f[(s + 1) & 1][jn] = *(const LAS bf16x8*)(fb + (((s + 1) * 4 + jn) * 64 + lane) * 16); }
#pragma unroll
        for (int jn = 0; jn < 4; ++jn) acc[jn] = __builtin_amdgcn_mfma_f32_32x32x16_bf16(a[s], f[s & 1][jn], acc[jn], 0, 0, 0);
        asm volatile("" ::: "memory");
    }
}
__device__ __forceinline__ void phase_s5a(const Frame& F0, const Params& P, bool bg) {
    const Frame F = refresh(F0);
    const bf16_t* Hg = (const bf16_t*)(F.ws + WS_H); bf16_t* SIN = (bf16_t*)(F.ws + WS_BIG + B_SIN);
    for (int item = F.blk; item < 256; item += F.G) {
        const int gd = item >> 1, g = gd >> 1, dir = gd & 1;
        __syncthreads();
        { const u32x4* src = (const u32x4*)((const bf16_t*)(F.ws + WS_S5FB) + (size_t)gd * 32 * 512); LAS u32x4* dst = (LAS u32x4*)F.lds;
          for (int i = F.tid; i < 2048; i += 512) dst[i] = src[i]; }
        __syncthreads();
        if (F.wave < 2) {
            const int pair = (item & 1) * 2 + F.wave; const int lane = F.lane, rho = lane & 31, h = lane >> 5, ncol = rho, hi = h;
            const int bA = pair * 2 + ((rho >> 2) & 1), rA = (rho & 3) + 4 * (rho >> 3);
            const int bS = pair * 2 + hi;
            const float* L8 = (const float*)(F.ws + WS_S5L8) + (size_t)gd * 128;
            const float a0r = L8[ncol * 2], a0i = L8[ncol * 2 + 1], a1r = L8[(32 + ncol) * 2], a1i = L8[(32 + ncol) * 2 + 1];
            float s0r = 0.f, s0i = 0.f, s1r = 0.f, s1i = 0.f;
            bf16_t* sinb = SIN + ((size_t)(g * 2 + dir) * 8 + bS) * 544 * 128;
            { unsigned* z = (unsigned*)sinb; z[ncol] = 0u; z[32 + ncol] = 0u; }
            const bf16_t* hgb = Hg + (size_t)g * MT * 16 + 8 * h;
            bf16x8 ua[8], un[8];
            { int row0; s5_chunk_rows(dir, bA, rA, row0);
#pragma unroll
              for (int s = 0; s < 8; ++s) ua[s] = *(const GAS bf16x8*)(hgb + (size_t)(row0 + s) * 16); }
            for (int tile = 0; tile < 34; ++tile) {
                { int row0; s5_chunk_rows(dir, bA, (tile < 33 ? tile + 1 : tile) * 16 + rA, row0);
#pragma unroll
                  for (int s = 0; s < 8; ++s) un[s] = *(const GAS bf16x8*)(hgb + (size_t)(row0 + s) * 16); }
                f32x16 acc[4];
#pragma unroll
                for (int jn = 0; jn < 4; ++jn) acc[jn] = f32x16{};
                s5_mfma_stage(acc, ua, F.lds, lane);
                unsigned* dbase = (unsigned*)(sinb + (size_t)(tile * 16 + 1) * 128) + ncol;
#pragma unroll
                for (int r = 0; r < 16; ++r) {
                    float nr = a0r * s0r - a0i * s0i + acc[0][r], ni = a0r * s0i + a0i * s0r + acc[1][r]; s0r = nr; s0i = ni;
                    nr = a1r * s1r - a1i * s1i + acc[2][r]; ni = a1r * s1i + a1i * s1r + acc[3][r]; s1r = nr; s1i = ni;
                    if (r < 15 || tile < 33) { dbase[r * 64] = pk2(s0r, s0i); dbase[r * 64 + 32] = pk2(s1r, s1i); } }
#pragma unroll
                for (int s = 0; s < 8; ++s) ua[s] = un[s];
            }
        }
        else if (bg && item == F.blk) bg_items(P, F.ws, BG_S5A_LO, BG_S5A_HI, F.blk * 6 + (F.wave - 2), F.G * 6, F.lane, F.lds + 32768 + (F.wave - 2) * 12288);
    }
    __syncthreads();
}
__device__ __forceinline__ void phase_s5b(const Frame& F0) {
    const Frame F = refresh(F0);
    const bf16_t* Hg = (const bf16_t*)(F.ws + WS_H); const bf16_t* SIN = (const bf16_t*)(F.ws + WS_BIG + B_SIN); bf16_t* Gout = (bf16_t*)(F.ws + WS_BIG + B_G);
    for (int item = F.blk; item < 256; item += F.G) {
        const int g = item >> 2, qt = item & 3;
        __syncthreads();
        { const u32x4* s1 = (const u32x4*)((const bf16_t*)(F.ws + WS_S5MB) + (size_t)g * 32 * 512); const u32x4* s2 = (const u32x4*)((const bf16_t*)(F.ws + WS_S5EB) + (size_t)g * 64 * 512); LAS u32x4* dst = (LAS u32x4*)F.lds;
          for (int i = F.tid; i < 2048; i += 512) dst[i] = s1[i];
          for (int i = F.tid; i < 4096; i += 512) dst[2048 + i] = s2[i]; }
        __syncthreads();
        const int lane = F.lane, rho = lane & 31, h = lane >> 5;
        for (int tile = qt * 34 + F.wave; tile < qt * 34 + 34; tile += 8) {
            const int b = tile / 17, tq = tile % 17;
            const int rowbase = tq == 0 ? NLAT + b * CTX : b * SEQ + (tq - 1) * 256;
            const int cc = tq * 32 + rho; const int Pf = cc, Pr = tq == 0 ? 31 - cc : 575 - cc;
            const bf16_t* up = Hg + ((size_t)g * MT + rowbase + rho * 8) * 16 + 8 * h;
            const bf16_t* sf = SIN + (((size_t)(g * 2 + 0) * 8 + b) * 544 + Pf) * 128 + 8 * h; const bf16_t* sr = SIN + (((size_t)(g * 2 + 1) * 8 + b) * 544 + Pr) * 128 + 8 * h;
            f32x16 acc[4];
#pragma unroll
            for (int jn = 0; jn < 4; ++jn) acc[jn] = f32x16{};
            bf16x8 a[8], af[8], ar[8];
#pragma unroll
            for (int s = 0; s < 8; ++s) { a[s] = *(const GAS bf16x8*)(up + 16 * s); af[s] = *(const GAS bf16x8*)(sf + 16 * s); ar[s] = *(const GAS bf16x8*)(sr + 16 * s); }
            s5_mfma_stage(acc, a, F.lds, lane);
            s5_mfma_stage(acc, af, F.lds + 32768, lane);
            s5_mfma_stage(acc, ar, F.lds + 65536, lane);
            const int col = lane & 31, n = col & 15, toff = col >> 4;
            bf16_t* ob = Gout + (size_t)(rowbase + 32 * h + toff) * DM + g * 16 + n;
#pragma unroll
            for (int r = 0; r < 16; ++r)
#pragma unroll
                for (int jn = 0; jn < 4; ++jn) ob[(size_t)(8 * ((r & 3) + 8 * (r >> 2)) + 2 * jn) * DM] = (bf16_t)f2bf(gelu_tanh(acc[jn][r]));
        }
    }
    __syncthreads();
}

constexpr int LDS_BYTES = 163840;
constexpr int LDSCTL_OFF = 159744;
constexpr int N_PHASES = 33;

__device__ __forceinline__ unsigned char* wmla(unsigned char* ws, int j) { return ws + WS_W + WO_MLA + (size_t)j * W_MLA_SZ; }

__device__ __forceinline__ void moe_fixup(const Frame& F0, const pg8::Sched& S, bf16_t* Y, const float* SLAB) {
    const Frame F = refresh(F0);
    const int R = S.nwg / S.G, T = S.nwg - R * S.G;
    for (int task = F.gw; task < T * 256; task += F.NGW) { const int tu = task >> 8, r = task & 255; pg8::Unit u; S.map((long)R * S.G + tu, u);
        const bf16_t* SB = (const bf16_t*)SLAB; f32x4 a = {0.f, 0.f, 0.f, 0.f};
        for (int s = 0; s < S.S; ++s) { const u32x2 t_ = *(const GAS u32x2*)(SB + ((size_t)(s * T + tu) * 256 + r) * 256 + 4 * F.lane);
            a = a + (f32x4){__builtin_bit_cast(float, t_.x << 16), __builtin_bit_cast(float, t_.x & 0xffff0000u), __builtin_bit_cast(float, t_.y << 16), __builtin_bit_cast(float, t_.y & 0xffff0000u)}; }
        u32x2 w; w.x = pk2(a[0], a[1]); w.y = pk2(a[2], a[3]); *(GAS u32x2*)(Y + ((size_t)u.pm * 256 + r) * DM + u.pn * 256 + 4 * F.lane) = w; }
}

__global__ void __launch_bounds__(512, 2) fwd_kernel(Params P) {
    extern __shared__ __attribute__((aligned(16))) unsigned char lds_raw[];
    Frame F; F.lds = (LAS unsigned char*)lds_raw; F.tid = threadIdx.x; F.lane = F.tid & 63; F.wave = __builtin_amdgcn_readfirstlane(F.tid >> 6);
    F.blk = blockIdx.x; F.G = gridDim.x; F.gw = F.blk * 8 + F.wave; F.NGW = F.G * 8; F.ws = P.ws;
    unsigned char* ws = P.ws;
    const int lo = P.ph_lo, hi = P.ph_hi;
    { int t0 = threadIdx.x; asm volatile("" : "+v"(t0)); for (int u = t0; u < (LDS_BYTES - LDSCTL_OFF) / 4; u += 512) ((LAS unsigned*)(F.lds + LDSCTL_OFF))[u] = 0u; }
    __syncthreads();
    unsigned* barw = (unsigned*)(ws + CTL_BAR) + (size_t)P.li * XCD_BAR_WORDS;
    XcdBarrier bar; bar.bar = barw; bar.x = 0; bar.st = (volatile LAS unsigned*)(F.lds + LDSCTL_OFF + 64);
    if (hi - lo > 1) bar = xcd_barrier_post(barw, (volatile LAS unsigned*)(F.lds + LDSCTL_OFF + 64));
#ifndef ONLY_LO
#define ONLY_LO 0
#define ONLY_HI 99
#endif
#define IN(k) ((k) >= ONLY_LO && (k) < ONLY_HI && lo <= (k) && (k) < hi)
#define SEAM(k) do { if (IN((k) + 1)) xcd_barrier(bar); } while (0)
    float* MOD = (float*)(ws + CTL_MOD); bf16_t* X = (bf16_t*)(ws + WS_X); bf16_t* H = (bf16_t*)(ws + WS_H); unsigned char* BIG = ws + WS_BIG;
    float* SSQ = (float*)(ws + WS_SSQ); const f32x2* ROPE_T = (const f32x2*)(ws + WS_ROPE);
    const int* TILEE = (const int*)(ws + WS_TILEE);
    const int vcu = (F.G % 8 == 0) ? (F.blk % 8) * (F.G / 8) + F.blk / 8 : F.blk;
    const int c2 = (F.G % 8 == 0 && F.G >= 256) ? (F.blk + F.G / 2) % F.G : F.blk;

#ifndef T_NOKR
#define T_NOKR 0
#endif
#ifndef T_NOUQ
#define T_NOUQ 0
#endif
#ifndef T_NOKV
#define T_NOKV 0
#endif
    const bool BGMODE = (F.G == 256) && !P.pad;
    bf16_t* Xr = P.pad ? (bf16_t*)(BIG + (size_t)360 * MiB) : X;
#define MODP(l, k) (MOD + (size_t)(l) * 9 * 6144 + (k) * 1024)
#define GEMMX(EPI, e, Aptr, lda_, Bptr, K_, nM_, nN_, cc, SPLIT) do { pg8::Sched S; S.init((nM_), (nN_), F.G, (cc), (K_) / 64, (SPLIT)); S.A = (const char*)(Aptr); S.a_tile = (size_t)256 * (lda_) * 2; S.B = (const char*)(Bptr); S.b_tile = (size_t)256 * (K_) * 2; \
        pg8::gemm_phase<EPI>(F.lds, (K_), (lda_), S, e); } while (0)
#define GEMM(EPI, e, Aptr, lda_, Bptr, K_, nM_, nN_, cc) GEMMX(EPI, e, Aptr, lda_, Bptr, K_, nM_, nN_, cc, false)

    if (IN(0)) { phase_p0(F, P); SEAM(0); }

#define MLA_LAYER(PH, L, J, QROWS_TILES, CTXQ) \
    if (IN(PH)) { EpiZ e{(bf16_t*)(BIG + B_Z), SSQ}; GEMM(EpiZ, e, H, DM, wmla(ws, J) + W_DQKV, DM, MT / 256, 3, F.blk); SEAM(PH); } \
    if (IN(PH + 1)) { if (!T_NOKR) phase_krope(F, MT); \
        if (!T_NOUQ) { EpiQ e{(bf16_t*)(BIG + B_Q), SSQ, ROPE_T}; GEMM(EpiQ, e, BIG + B_Z, ZW, wmla(ws, J) + W_UQ, QLORA, QROWS_TILES, 6, F.blk); } \
        if (!T_NOKV) { EpiKV e{(bf16_t*)(BIG + B_K), (bf16_t*)(BIG + B_V), SSQ}; GEMM(EpiKV, e, BIG + B_Z + QLORA * 2, ZW, wmla(ws, J) + W_UKV, KVLORA, MT / 256, 8, c2); } \
        SEAM(PH + 1); } \
    if (IN(PH + 2)) { const bf16_t* Qb = (const bf16_t*)(BIG + B_Q); const bf16_t* Kb = (const bf16_t*)(BIG + B_K); const bf16_t* Vb = (const bf16_t*)(BIG + B_V); const bf16_t* KRb = (const bf16_t*)(BIG + B_KR); \
        for (int ui = vcu; ui < NB * NHEAD * 16; ui += F.G) { const int bh = ui >> 4, qb = ui & 15, b = bh >> 4, h = bh & 15; \
            att::attn_unit(Qb, Kb, Vb, H, KRb, b * SEQ + qb * 256, NLAT + b * CTX, b * SEQ, h, 68, F.lds); } \
        if (CTXQ) for (int ui = vcu; ui < NB * NHEAD; ui += F.G) { const int b = ui >> 4, h = ui & 15; att::attn_unit(Qb, Kb, Vb, H, KRb, NLAT + b * CTX, NLAT + b * CTX, b * SEQ, h, 4, F.lds); } \
        SEAM(PH + 2); } \
    if (IN(PH + 3)) { EpiResid e{Xr, MODP(L, 2), nullptr, (float*)(BIG + B_SLAB)}; GEMMX(EpiResid, e, H, DM, wmla(ws, J) + W_O, DM, QROWS_TILES, 4, F.blk, (L) == 0 && !P.pad); SEAM(PH + 3); }

#define FFN_LAYER(PH, L, KF) \
    if (IN(PH)) { EpiSwiGLU e{(bf16_t*)BIG}; GEMM(EpiSwiGLU, e, H, DM, ws + WS_W + WO_FFN + (size_t)(KF) * W_FFN_SZ, DM, MT / 256, 22, F.blk); SEAM(PH); } \
    if (IN(PH + 1)) { EpiResid e{Xr, MODP(L, 5), nullptr, (float*)(BIG + B_SLAB)}; GEMMX(EpiResid, e, BIG, FFN, ws + WS_W + WO_FFN + (size_t)(KF) * W_FFN_SZ + W_GU_SZ, FFN, MT / 256, 4, F.blk, !P.pad); SEAM(PH + 1); }

#define MOE_LAYER(PH, KM, NROWS) \
    if (IN(PH)) { phase_scatter(F, NROWS); SEAM(PH); } \
    if (IN(PH + 1)) { const int ntm = __builtin_amdgcn_readfirstlane(TILEE[511]); pg8::Sched S; S.init(ntm, 22, F.G, F.blk, DM / 64); S.A = (const char*)H; S.a_tile = 0; S.gather = (const int*)(ws + WS_S2R); \
        S.B = (const char*)(ws + WS_W + WO_MOE + (size_t)(KM) * 8 * W_FFN_SZ); S.b_tile = (size_t)256 * DM * 2; S.b_exp = W_FFN_SZ; S.tile_e = TILEE; \
        EpiSwiGLU e{(bf16_t*)(BIG + B_ACTM)}; pg8::gemm_phase<EpiSwiGLU, true, true>(F.lds, DM, DM, S, e); SEAM(PH + 1); } \
    if (IN(PH + 2)) { const int ntm = __builtin_amdgcn_readfirstlane(TILEE[511]); pg8::Sched S; const bool msplit = (KM) == 1 && !P.pad && (hi - lo > 1);     \
        S.init(ntm, 4, F.G, F.blk, FFN / 64, msplit, 8); S.A = (const char*)(BIG + B_ACTM); S.a_tile = (size_t)256 * FFN * 2; \
        S.B = (const char*)(ws + WS_W + WO_MOE + (size_t)(KM) * 8 * W_FFN_SZ + W_GU_SZ); S.b_tile = (size_t)256 * FFN * 2; S.b_exp = W_FFN_SZ; S.tile_e = TILEE; \
        EpiBf16 e{(bf16_t*)(BIG + B_XG), DM, (float*)(ws + WS_SLAB2)}; pg8::gemm_phase<EpiBf16>(F.lds, FFN, FFN, S, e); \
        if (BGMODE && (KM) == 0) { int sc0 = (ntm * 4) % 256; if (256 - sc0 < 128) sc0 = 0; bg_convert(F, P, BG_R16_LO, BG_R16_HI, F.blk, sc0); } \
        if (S.S > 1) { xcd_barrier(bar); moe_fixup(F, S, (bf16_t*)(BIG + B_XG), (const float*)(ws + WS_SLAB2)); }     \
        SEAM(PH + 2); }

    if (IN(1)) { phase_rows<1, false, 0, false>(F, P, MT, P.in[I_N1G] + 0 * DM, MODP(0, 0), nullptr, 0, nullptr, nullptr, 0); SEAM(1); }
    MLA_LAYER(2, 0, 0, MT / 256, true)
    if (IN(6)) { phase_rows<0, false, 0, false, true>(F, P, MT, P.in[I_N2G] + 0 * DM, MODP(0, 3), nullptr, 0, nullptr, nullptr, 0, DM / 64); SEAM(6); }
    FFN_LAYER(7, 0, 0)
    if (IN(9)) { phase_rows<0, false, 1, false, true>(F, P, MT, P.in[I_N1G] + 1 * DM, MODP(1, 0), nullptr, 0, nullptr, nullptr, 0, FFN / 64); SEAM(9); }
    if (IN(10)) { phase_s5a(F, P, BGMODE); SEAM(10); }
    if (IN(11)) { phase_s5b(F); SEAM(11); }
    if (IN(12)) { EpiGLU e{X, MODP(1, 2)}; GEMM(EpiGLU, e, BIG + B_G, DM, ws + WS_W + WO_GLU, DM, MT / 256, 8, F.blk); if (BGMODE) bg_convert(F, P, BG_R12_LO, BG_R12_HI, F.blk, 64); SEAM(12); }
    if (IN(13)) { phase_rows<0, false, 0, true>(F, P, MT, P.in[I_N2G] + 1 * DM, MODP(1, 3), nullptr, 0, P.in[I_MRW], P.in[I_MRB], MT); SEAM(13); }
    MOE_LAYER(14, 0, MT)
    if (IN(17)) { phase_rows<0, true, 0, false>(F, P, MT, P.in[I_N1G] + 2 * DM, MODP(2, 0), MODP(1, 5), MT, nullptr, nullptr, 0); SEAM(17); }
    if (IN(18)) { phase_pool(F); SEAM(18); }
    if (IN(19)) { pg8::Sched S; S.init(MT / 256, 4, F.G, F.blk, 256 / 64); S.A = (const char*)BIG; S.a_tile = (size_t)256 * DM * 2; S.a_pn = 512; S.B = (const char*)(ws + WS_W + WO_POOL); S.b_tile = (size_t)256 * 256 * 2;
        EpiResidT<true> e{X, MODP(2, 2), P.in[I_POOLS], nullptr}; pg8::gemm_phase<EpiResidT<true>>(F.lds, 256, DM, S, e); SEAM(19); }
    if (IN(20)) { phase_rows<0, false, 0, false>(F, P, MT, P.in[I_N2G] + 2 * DM, MODP(2, 3), nullptr, 0, nullptr, nullptr, 0); SEAM(20); }
    FFN_LAYER(21, 2, 1)
    if (IN(23)) { phase_rows<0, false, 0, false, true>(F, P, MT, P.in[I_N1G] + 3 * DM, MODP(3, 0), nullptr, 0, nullptr, nullptr, 0, FFN / 64); SEAM(23); }
    MLA_LAYER(24, 3, 1, NLAT / 256, false)
    if (IN(28)) { phase_rows<0, false, 0, true>(F, P, NLAT, P.in[I_N2G] + 3 * DM, MODP(3, 3), nullptr, 0, P.in[I_MRW] + DM * NEXP, P.in[I_MRB] + NEXP, NLAT); SEAM(28); }
    MOE_LAYER(29, 1, NLAT)
    if (IN(32)) { phase_rows<0, true, 2, false>(F, P, NLAT, P.in[I_FNG], nullptr, MODP(3, 5), NLAT, nullptr, nullptr, 0); }
#undef IN
#undef SEAM
}

#ifndef MK_PER_PHASE
#define MK_PER_PHASE 0
#endif
extern "C" void kernel_launch(void* const* d_in, const int* in_sizes, int n_in, void* d_out, int out_size, void* d_ws, size_t ws_size, hipStream_t stream) {
    static int grid = 0;
    if (grid == 0) {
        if (n_in != 33 || ws_size < WS_END) { fprintf(stderr, "kernel_launch: n_in %d ws %zu (need %zu)\n", n_in, ws_size, (size_t)WS_END); grid = -1; return; }
        int dev = 0, cus = 0;
        if (hipGetDevice(&dev) != hipSuccess || hipDeviceGetAttribute(&cus, hipDeviceAttributeMultiprocessorCount, dev) != hipSuccess) { grid = -1; return; }
        if (hipFuncSetAttribute((const void*)fwd_kernel, hipFuncAttributeMaxDynamicSharedMemorySize, LDS_BYTES) != hipSuccess) { grid = -1; return; }
        int per_cu = 0; (void)hipOccupancyMaxActiveBlocksPerMultiprocessor(&per_cu, (const void*)fwd_kernel, 512, LDS_BYTES); (void)hipGetLastError();
        grid = cus > 256 ? 256 : cus;
    }
    if (grid < 0) return;
    (void)hipMemsetAsync((char*)d_ws + WS_CTL, 0, CTL_ZERO_BYTES, stream);
    Params p{};
    for (int i = 0; i < 33; ++i) p.in[i] = (const float*)d_in[i];
    p.out = (float*)d_out; p.ws = (unsigned char*)d_ws;
#if MK_PER_PHASE
    for (int k = 0; k < N_PHASES; ++k) { p.ph_lo = k; p.ph_hi = k + 1; hipLaunchKernelGGL(fwd_kernel, dim3(grid), dim3(512), LDS_BYTES, stream, p); }
#elif defined(PROBE_REPEAT)
    {
      const int rep[] = {PROBE_REPEAT}; const int nrep = sizeof(rep) / sizeof(rep[0]); int prev = 0;
      for (int i = 0; i < nrep; ++i) { p.li = i; p.ph_lo = prev; p.ph_hi = rep[i] + 1; hipLaunchKernelGGL(fwd_kernel, dim3(grid), dim3(512), LDS_BYTES, stream, p);
          p.ph_lo = rep[i]; p.ph_hi = rep[i] + 1; p.pad = 1; hipLaunchKernelGGL(fwd_kernel, dim3(grid), dim3(512), LDS_BYTES, stream, p); p.pad = 0; prev = rep[i] + 1; }
      if (prev < N_PHASES) { p.li = nrep; p.ph_lo = prev; p.ph_hi = N_PHASES; hipLaunchKernelGGL(fwd_kernel, dim3(grid), dim3(512), LDS_BYTES, stream, p); } }
#else
    p.ph_lo = 0; p.ph_hi = N_PHASES; hipLaunchKernelGGL(fwd_kernel, dim3(grid), dim3(512), LDS_BYTES, stream, p);
#endif
}
```
